# Optimizing an MI355X kernel written in HIP

```python
import jax
import jax.numpy as jnp
from jax import lax
import numpy as np

D_MODEL = 2048
BATCH = 4
SEQ = 2048
DEPTH = 2

GRID_W = 64
CTX_LEN = 256
NORM_EPS = 1e-6
N_BRANCH = 4
BRANCH_W = D_MODEL // N_BRANCH

FNO_GROUPS = 4
FNO_GROUP_W = BRANCH_W // FNO_GROUPS

RWKV_HEAD = 64
RWKV_HEADS = BRANCH_W // RWKV_HEAD
N_DIR = 2
DECAY_LORA = 64
AICL_LORA = 64
GATE_LORA = 128
DIR_LORA_W = DECAY_LORA + AICL_LORA
SHIFT_W = 3 * BRANCH_W + DIR_LORA_W
GN_EPS = 64e-5

ATT_HEAD = 64
ATT_HEADS = BRANCH_W // ATT_HEAD
ATT_KV_HEADS = 2
ATT_REP = ATT_HEADS // ATT_KV_HEADS
ATT_KV_W = ATT_KV_HEADS * ATT_HEAD
WINDOW = 128
BLOCK = 128
ROPE_BASE = 10000.0
NEG_INF = -1e30

CONV_K = 31
LN_EPS = 1e-5

MLP_HIDDEN = 4 * D_MODEL

O_RKV = 0
O_LORA = O_RKV + 3 * BRANCH_W
O_KV = O_LORA + N_DIR * DIR_LORA_W
CTX_STATE_COLS = O_KV + 2 * ATT_KV_W
O_G = CTX_STATE_COLS
O_Q = O_G + GATE_LORA
O_FNO = O_Q + BRANCH_W
O_CONV = O_FNO + BRANCH_W
O_GATE = O_CONV + 2 * BRANCH_W
IN_W = O_GATE + N_BRANCH * D_MODEL

F32 = jnp.float32

kernel_name = 'hybrid_fourier_rwkv7_swa_conformer_dit'


def to_heads(t, n):
    return t.reshape(t.shape[:-1] + (n, t.shape[-1] // n))


def rmsnorm(t, g):
    t32 = t.astype(F32)
    y = t32 * lax.rsqrt(jnp.mean(t32 * t32, axis=-1, keepdims=True) + NORM_EPS)
    return (y * g.astype(F32)).astype(t.dtype)


def token_shift(t, forward):
    if forward:
        return jnp.pad(t[:, :-1], ((0, 0), (1, 0), (0, 0)))
    return jnp.pad(t[:, 1:], ((0, 0), (0, 1), (0, 0)))


def fourier_mix(u):
    B, L, _ = u.shape
    g = u.astype(F32).reshape(B, L, FNO_GROUPS, FNO_GROUP_W)
    f = jnp.fft.fft2(g, axes=(1, 3), norm='ortho').real
    return f.reshape(B, L, BRANCH_W).astype(u.dtype)


def rwkv_scan_inputs(p, mu, w0, w_up, a0, a_up, k_k, k_a):
    rkv = p[..., :3 * BRANCH_W]
    per_dir = []
    for d in range(N_DIR):
        lo = O_LORA + d * DIR_LORA_W
        f = jnp.concatenate([rkv, p[..., lo:lo + DIR_LORA_W]], axis=-1)
        f = f + mu[d] * (token_shift(f, forward=(d == 0)) - f)
        r, k, v, wl, al = jnp.split(
            f, [BRANCH_W, 2 * BRANCH_W, 3 * BRANCH_W, 3 * BRANCH_W + DECAY_LORA], axis=-1)
        w_raw = (w0[d] + jnp.tanh(wl) @ w_up[d]).astype(F32)
        decay = jnp.exp(-jnp.exp(-jax.nn.softplus(-w_raw) - 0.5))
        a = jax.nn.sigmoid((a0[d] + al @ a_up[d]).astype(F32))
        kk = to_heads((k * k_k).astype(F32), RWKV_HEADS)
        kk = kk / jnp.maximum(jnp.sqrt(jnp.sum(kk * kk, axis=-1, keepdims=True)), 1e-12)
        k_rep = k.astype(F32) * (1.0 + (a - 1.0) * k_a.astype(F32))
        per_dir.append([to_heads(r.astype(F32), RWKV_HEADS), to_heads(decay, RWKV_HEADS),
                        to_heads(k_rep, RWKV_HEADS), to_heads(v.astype(F32), RWKV_HEADS),
                        kk, to_heads(a, RWKV_HEADS)])
    return tuple(jnp.stack([per_dir[0][i], per_dir[1][i]]) for i in range(6))


def wkv7_scan(state0, ins, emit):
    def time_major(t):
        t = jnp.stack([t[0], jnp.flip(t[1], axis=1)])
        return jnp.moveaxis(t, 2, 0)

    xs = tuple(time_major(t) for t in ins)

    def step(S, inp):
        r, w, k, v, kk, a = inp
        sa = jnp.einsum('dbhvk,dbhk->dbhv', S, -kk)
        S = (S * w[..., None, :] + sa[..., :, None] * (kk * a)[..., None, :]
             + v[..., :, None] * k[..., None, :])
        y = jnp.einsum('dbhvk,dbhk->dbhv', S, r) if emit else None
        return S, y

    S, ys = lax.scan(step, state0, xs)
    if emit:
        ys = jnp.moveaxis(ys, 0, 2)
        ys = ys[0] + jnp.flip(ys[1], axis=1)
    return S, ys


def rwkv_readout(y, ins, g_in, g_up, r_k, lnx_g, lnx_b, dtype):
    r, _, k, v, _, _ = ins
    B, L = y.shape[:2]
    mean = jnp.mean(y, axis=-1, keepdims=True)
    var = jnp.mean(jnp.square(y - mean), axis=-1, keepdims=True)
    yn = ((y - mean) * lax.rsqrt(var + GN_EPS)).reshape(B, L, BRANCH_W)
    yn = yn * lnx_g.astype(F32) + lnx_b.astype(F32)
    bonus = jnp.sum(jnp.sum(r * k * r_k[:, None, None].astype(F32), axis=-1, keepdims=True) * v, axis=0)
    g = (jax.nn.sigmoid(g_in) @ g_up).astype(F32)
    return ((yn + bonus.reshape(B, L, BRANCH_W)) * g).astype(dtype)


def axial_rope(t, row_ids, col_ids):
    half = t.shape[-1] // 2

    def rotate(u, pos):
        nf = u.shape[-1] // 2
        inv = ROPE_BASE ** (-jnp.arange(nf, dtype=F32) / nf)
        ang = pos.astype(F32)[:, None] * inv[None, :]
        cos = jnp.cos(ang)[None, :, None, :]
        sin = jnp.sin(ang)[None, :, None, :]
        u1 = u[..., :nf].astype(F32)
        u2 = u[..., nf:].astype(F32)
        return jnp.concatenate([u1 * cos - u2 * sin, u2 * cos + u1 * sin], axis=-1)

    out = jnp.concatenate([rotate(t[..., :half], row_ids), rotate(t[..., half:], col_ids)], axis=-1)
    return out.astype(t.dtype)


def window_attention(q, k, v, kc, vc, sink):
    B, S, H, dh = q.shape
    nb = S // BLOCK
    scale = dh ** -0.5
    qb = q.reshape(B, nb, BLOCK, ATT_KV_HEADS, ATT_REP, dh)

    def band(t):
        tp = jnp.pad(t, ((0, 0), (BLOCK, BLOCK), (0, 0), (0, 0)))
        tp = tp.reshape(B, nb + 2, BLOCK, ATT_KV_HEADS, dh)
        return jnp.concatenate([tp[:, :-2], tp[:, 1:-1], tp[:, 2:]], axis=2)

    kw, vw = band(k), band(v)
    s_loc = jnp.einsum('bnqgrd,bnkgd->bngrqk', qb, kw).astype(F32) * scale
    blk = jnp.arange(nb)[:, None, None] * BLOCK
    qpos = blk + jnp.arange(BLOCK)[None, :, None]
    kpos = blk - BLOCK + jnp.arange(3 * BLOCK)[None, None, :]
    valid = (jnp.abs(kpos - qpos) <= WINDOW) & (kpos >= 0) & (kpos < S)
    s_loc = jnp.where(valid[None, :, None, None], s_loc, NEG_INF)
    s_ctx = jnp.einsum('bnqgrd,bcgd->bngrqc', qb, kc).astype(F32) * scale
    s_sink = jnp.broadcast_to(sink.astype(F32).reshape(1, 1, ATT_KV_HEADS, ATT_REP, 1, 1),
                              s_loc.shape[:-1] + (1,))
    p = jax.nn.softmax(jnp.concatenate([s_loc, s_ctx, s_sink], axis=-1), axis=-1)
    nk = 3 * BLOCK
    nc = kc.shape[1]
    o = (jnp.einsum('bngrqk,bnkgd->bnqgrd', p[..., :nk].astype(v.dtype), vw)
         + jnp.einsum('bngrqc,bcgd->bnqgrd', p[..., nk:nk + nc].astype(vc.dtype), vc))
    return o.reshape(B, S, H * dh)


def context_attention(qc, kc, vc, sink):
    B, C, H, dh = qc.shape
    qg = qc.reshape(B, C, ATT_KV_HEADS, ATT_REP, dh)
    s = jnp.einsum('bqgrd,bkgd->bgrqk', qg, kc).astype(F32) * (dh ** -0.5)
    s_sink = jnp.broadcast_to(sink.astype(F32).reshape(1, ATT_KV_HEADS, ATT_REP, 1, 1), s.shape[:-1] + (1,))
    p = jax.nn.softmax(jnp.concatenate([s, s_sink], axis=-1), axis=-1)
    o = jnp.einsum('bgrqk,bkgd->bqgrd', p[..., :C].astype(vc.dtype), vc)
    return o.reshape(B, C, H * dh)


def conformer_conv(u, dw, dw_b, ln_g, ln_b):
    a, b = jnp.split(u, 2, axis=-1)
    h = a * jax.nn.sigmoid(b)
    h = lax.conv_general_dilated(h, dw[:, None, :].astype(h.dtype), (1,), 'SAME',
                                 dimension_numbers=('NWC', 'WIO', 'NWC'),
                                 feature_group_count=BRANCH_W) + dw_b
    h32 = h.astype(F32)
    mean = jnp.mean(h32, axis=-1, keepdims=True)
    var = jnp.mean(jnp.square(h32 - mean), axis=-1, keepdims=True)
    h32 = (h32 - mean) * lax.rsqrt(var + LN_EPS) * ln_g.astype(F32) + ln_b.astype(F32)
    return (h32 * jax.nn.sigmoid(h32)).astype(u.dtype)


def kv_heads(p):
    k = to_heads(p[..., O_KV:O_KV + ATT_KV_W], ATT_KV_HEADS)
    v = to_heads(p[..., O_KV + ATT_KV_W:CTX_STATE_COLS], ATT_KV_HEADS)
    return k, v


def branch_stack(p, ins, y, att, lp):
    fno = fourier_mix(p[..., O_FNO:O_FNO + BRANCH_W])
    rw = rwkv_readout(y, ins, p[..., O_G:O_G + GATE_LORA], lp['rwkv_g_up'], lp['rwkv_r_k'],
                      lp['rwkv_lnx_g'], lp['rwkv_lnx_b'], p.dtype)
    cv = conformer_conv(p[..., O_CONV:O_CONV + 2 * BRANCH_W], lp['conv_dw'], lp['conv_dw_b'],
                        lp['conv_ln_g'], lp['conv_ln_b'])
    return jnp.stack([fno, rw, att.astype(p.dtype), cv], axis=2)


def merge_branches(feats, gate_logits, w_branch, w_out):
    B, L = feats.shape[:2]
    proj = jnp.einsum('blif,ifd->blid', feats, w_branch)
    gate = jax.nn.sigmoid(gate_logits.reshape(B, L, N_BRANCH, D_MODEL))
    return jnp.einsum('blid,de->ble', proj * gate, w_out)


def hybrid_mixer(hx, hc, row_ids, col_ids, lp, with_ctx):
    B = hx.shape[0]
    px = hx @ lp['w_in']
    pc = hc @ (lp['w_in'] if with_ctx else lp['w_in'][:, :CTX_STATE_COLS])
    scan_args = (lp['rwkv_mu'], lp['rwkv_w0'], lp['rwkv_w_up'], lp['rwkv_a0'], lp['rwkv_a_up'],
                 lp['rwkv_k_k'], lp['rwkv_k_a'])
    ins_c = rwkv_scan_inputs(pc[..., :O_KV], *scan_args)
    ins_x = rwkv_scan_inputs(px[..., :O_KV], *scan_args)
    state0 = jnp.zeros((N_DIR, B, RWKV_HEADS, RWKV_HEAD, RWKV_HEAD), F32)
    state_c, y_c = wkv7_scan(state0, ins_c, emit=with_ctx)
    _, y_x = wkv7_scan(state_c, ins_x, emit=True)
    kc, vc = kv_heads(pc)
    kx, vx = kv_heads(px)
    qx = axial_rope(to_heads(px[..., O_Q:O_Q + BRANCH_W], ATT_HEADS), row_ids, col_ids)
    kx = axial_rope(kx, row_ids, col_ids)
    att_x = window_attention(qx, kx, vx, kc, vc, lp['att_sink'])
    out_x = merge_branches(branch_stack(px, ins_x, y_x, att_x, lp), px[..., O_GATE:],
                           lp['w_branch'], lp['w_out'])
    if not with_ctx:
        return out_x, None
    qc = to_heads(pc[..., O_Q:O_Q + BRANCH_W], ATT_HEADS)
    att_c = context_attention(qc, kc, vc, lp['att_sink'])
    out_c = merge_branches(branch_stack(pc, ins_c, y_c, att_c, lp), pc[..., O_GATE:],
                           lp['w_branch'], lp['w_out'])
    return out_x, out_c


def sq_relu_mlp(h, w1, w2):
    return jnp.square(jax.nn.relu(h @ w1)) @ w2


def setup_inputs(seed: int = 0) -> dict:
    key = jax.random.key(seed)
    ks = jax.random.split(key, 32)
    D = D_MODEL

    def nrm(k, shape, s):
        return jax.random.normal(k, shape, F32) * s

    return {
        'x': nrm(ks[0], (BATCH, SEQ, D), 1.0),
        'c': nrm(ks[1], (BATCH, D), 1.0),
        'ctx': nrm(ks[2], (BATCH, CTX_LEN, D), 1.0),
        'c_ctx': nrm(ks[3], (D,), 1.0),
        'ada_w': nrm(ks[4], (DEPTH, D, 6 * D), 0.5 * D ** -0.5),
        'ada_b': nrm(ks[5], (DEPTH, 6 * D), 0.02),
        'norm1_g': 1.0 + nrm(ks[6], (DEPTH, D), 0.02),
        'norm2_g': 1.0 + nrm(ks[7], (DEPTH, D), 0.02),
        'w_in': nrm(ks[8], (DEPTH, D, IN_W), D ** -0.5),
        'rwkv_mu': jax.random.uniform(ks[9], (DEPTH, N_DIR, SHIFT_W), F32),
        'rwkv_w0': nrm(ks[10], (DEPTH, N_DIR, BRANCH_W), 0.5),
        'rwkv_w_up': nrm(ks[11], (DEPTH, N_DIR, DECAY_LORA, BRANCH_W), DECAY_LORA ** -0.5),
        'rwkv_a0': nrm(ks[12], (DEPTH, N_DIR, BRANCH_W), 0.5),
        'rwkv_a_up': nrm(ks[13], (DEPTH, N_DIR, AICL_LORA, BRANCH_W), AICL_LORA ** -0.5),
        'rwkv_k_k': 0.85 + nrm(ks[14], (DEPTH, BRANCH_W), 0.05),
        'rwkv_k_a': 1.0 + nrm(ks[15], (DEPTH, BRANCH_W), 0.05),
        'rwkv_r_k': nrm(ks[16], (DEPTH, N_DIR, RWKV_HEADS, RWKV_HEAD), 0.1),
        'rwkv_g_up': nrm(ks[17], (DEPTH, GATE_LORA, BRANCH_W), GATE_LORA ** -0.5),
        'rwkv_lnx_g': 1.0 + nrm(ks[18], (DEPTH, BRANCH_W), 0.02),
        'rwkv_lnx_b': nrm(ks[19], (DEPTH, BRANCH_W), 0.02),
        'att_sink': nrm(ks[20], (DEPTH, ATT_HEADS), 1.0),
        'conv_dw': nrm(ks[21], (DEPTH, CONV_K, BRANCH_W), CONV_K ** -0.5),
        'conv_dw_b': nrm(ks[22], (DEPTH, BRANCH_W), 0.02),
        'conv_ln_g': 1.0 + nrm(ks[23], (DEPTH, BRANCH_W), 0.02),
        'conv_ln_b': nrm(ks[24], (DEPTH, BRANCH_W), 0.02),
        'w_branch': nrm(ks[25], (DEPTH, N_BRANCH, BRANCH_W, D), BRANCH_W ** -0.5),
        'w_out': nrm(ks[26], (DEPTH, D, D), D ** -0.5),
        'w_mlp1': nrm(ks[27], (DEPTH, D, MLP_HIDDEN), D ** -0.5),
        'w_mlp2': nrm(ks[28], (DEPTH, MLP_HIDDEN, D), MLP_HIDDEN ** -0.5),
        'final_g': 1.0 + nrm(ks[29], (D,), 0.02),
    }


def reference(x, c, ctx, c_ctx, ada_w, ada_b, norm1_g, norm2_g, w_in, rwkv_mu, rwkv_w0, rwkv_w_up,
              rwkv_a0, rwkv_a_up, rwkv_k_k, rwkv_k_a, rwkv_r_k, rwkv_g_up, rwkv_lnx_g, rwkv_lnx_b,
              att_sink, conv_dw, conv_dw_b, conv_ln_g, conv_ln_b, w_branch, w_out, w_mlp1, w_mlp2,
              final_g):
    D = D_MODEL
    rows = x.shape[1] // GRID_W
    row_ids = jnp.repeat(jnp.arange(rows, dtype=jnp.int32), GRID_W)
    col_ids = jnp.tile(jnp.arange(GRID_W, dtype=jnp.int32), rows)
    silu_c = jax.nn.silu(c)
    silu_cc = jax.nn.silu(c_ctx)
    h_ctx = ctx
    for l in range(DEPTH):
        with_ctx = l < DEPTH - 1
        lp = {
            'w_in': w_in[l], 'rwkv_mu': rwkv_mu[l], 'rwkv_w0': rwkv_w0[l], 'rwkv_w_up': rwkv_w_up[l],
            'rwkv_a0': rwkv_a0[l], 'rwkv_a_up': rwkv_a_up[l], 'rwkv_k_k': rwkv_k_k[l],
            'rwkv_k_a': rwkv_k_a[l], 'rwkv_r_k': rwkv_r_k[l], 'rwkv_g_up': rwkv_g_up[l],
            'rwkv_lnx_g': rwkv_lnx_g[l], 'rwkv_lnx_b': rwkv_lnx_b[l], 'att_sink': att_sink[l],
            'conv_dw': conv_dw[l], 'conv_dw_b': conv_dw_b[l], 'conv_ln_g': conv_ln_g[l],
            'conv_ln_b': conv_ln_b[l], 'w_branch': w_branch[l], 'w_out': w_out[l],
        }
        mod_x = silu_c @ ada_w[l] + ada_b[l]
        sh1, sc1, g1, sh2, sc2, g2 = jnp.split(mod_x[:, None, :], 6, axis=-1)
        n_mod = 6 if with_ctx else 2
        mod_c = jnp.split(silu_cc @ ada_w[l][:, :n_mod * D] + ada_b[l][:n_mod * D], n_mod)
        hx = rmsnorm(x, norm1_g[l]) * (1.0 + sc1) + sh1
        hc = rmsnorm(h_ctx, norm1_g[l]) * (1.0 + mod_c[1]) + mod_c[0]
        mix_x, mix_c = hybrid_mixer(hx, hc, row_ids, col_ids, lp, with_ctx)
        x = x + g1 * mix_x
        x = x + g2 * sq_relu_mlp(rmsnorm(x, norm2_g[l]) * (1.0 + sc2) + sh2, w_mlp1[l], w_mlp2[l])
        if with_ctx:
            h_ctx = h_ctx + mod_c[2] * mix_c
            hc2 = rmsnorm(h_ctx, norm2_g[l]) * (1.0 + mod_c[4]) + mod_c[3]
            h_ctx = h_ctx + mod_c[5] * sq_relu_mlp(hc2, w_mlp1[l], w_mlp2[l])
    return rmsnorm(x, final_g)
```

```cpp
#include <hip/hip_runtime.h>
#include <cstdio>
#include <cstdint>
#define HD __host__ __device__ __forceinline__
#define CONSTAS __attribute__((address_space(4)))
typedef unsigned short bf16;
HD float bf2f(bf16 h) { unsigned u = ((unsigned)h) << 16; float f; __builtin_memcpy(&f, &u, 4); return f; }
HD bf16 f2bf(float f) { unsigned u; __builtin_memcpy(&u, &f, 4); return (bf16)((u + 0x7fffu + ((u >> 16) & 1u)) >> 16); }
HD float sigmoidf_(float x) { return 1.0f / (1.0f + expf(-x)); }

template <int D_, int B_, int S_, int DEPTH_, int GW_, int CT_, int FG_, int RH_, int DL_, int AL_, int GL_, int AH_, int AKV_, int WIN_, int CK_>
struct CfgT {
    static constexpr int D = D_, B = B_, S = S_, DEPTH = DEPTH_, GW = GW_, CT = CT_;
    static constexpr int BW = D / 4, FG = FG_, FGW = BW / FG, RH = RH_, RNH = BW / RH, DL = DL_, AL = AL_, GL = GL_, DLW = DL + AL, SHW = 3 * BW + DLW;
    static constexpr int AH = AH_, ANH = BW / AH, AKV = AKV_, AREP = ANH / AKV, AKVW = AKV * AH, WIN = WIN_, CK = CK_, HID = 4 * D;
    static constexpr int O_LORA = 3 * BW, O_KV = O_LORA + 2 * DLW, CSC = O_KV + 2 * AKVW, O_G = CSC, O_Q = O_G + GL, O_FNO = O_Q + BW, O_CONV = O_FNO + BW,
                         O_GATE = O_CONV + 2 * BW, IN_W = O_GATE + 4 * D;
    static constexpr int PXW = (IN_W + 255) / 256 * 256;
    static constexpr int MX = B * S, MC = B * CT, MA = MX + MC;
};
typedef CfgT<2048, 4, 2048, 2, 64, 256, 4, 64, 64, 64, 128, 64, 2, 128, 31> CfgFull;
typedef CfgT<256, 2, 64, 2, 8, 16, 4, 16, 8, 8, 16, 16, 2, 8, 7> CfgSmall;

template <class C> struct WSMapT {
    static constexpr size_t al(size_t x) { return (x + 4095) / 4096 * 4096; }
};
constexpr size_t ws_al(size_t x) { return (x + 4095) / 4096 * 4096; }
template <class C> struct WSM {
    static constexpr size_t CTL = 0, CTL_BYTES = 1u << 20;
    static constexpr size_t MOD = CTL + CTL_BYTES;
    static constexpr size_t RSTD = MOD + ws_al((size_t)C::DEPTH * (C::B + 1) * 6 * C::D * 4);
    static constexpr size_t X = RSTD + ws_al((size_t)C::MA * 4);
    static constexpr size_t HX = X + ws_al((size_t)C::MA * C::D * 4);
    static constexpr size_t WREG = HX + ws_al((size_t)C::MA * C::D * 2);
    static constexpr size_t W2T = WREG, WoT = W2T + ws_al((size_t)C::D * C::HID * 2), WbT = WoT + ws_al((size_t)C::D * C::D * 2), U2 = WbT + ws_al((size_t)4 * C::D * C::BW * 2);
    static constexpr size_t WinT = U2, W1T = U2;
    static constexpr size_t WREG_END1 = WinT + ws_al((size_t)C::PXW * C::D * 2), WREG_END2 = W1T + ws_al((size_t)C::HID * C::D * 2);
    static constexpr size_t PX = WREG_END1 > WREG_END2 ? WREG_END1 : WREG_END2;
    static constexpr size_t PREP = PX + ws_al((size_t)C::MA * C::PXW * 2);
    static constexpr size_t PREP1 = ws_al((size_t)2 * C::MA * C::BW * 4);
    static constexpr size_t QR = PREP + 7 * PREP1;
    static constexpr size_t KR = QR + ws_al((size_t)C::MA * C::BW * 2);
    static constexpr size_t YT = KR + ws_al((size_t)C::MA * C::AKVW * 2);
    static constexpr size_t YTC = YT + ws_al((size_t)C::B * C::BW * 2 * C::S * 2);
    static constexpr size_t TX = YTC + ws_al((size_t)C::B * C::BW * 2 * C::CT * 2);
    static constexpr size_t TC = TX + ws_al((size_t)C::S * 2 * C::S * 2);
    static constexpr size_t FEATS = TC + ws_al((size_t)C::CT * 2 * C::CT * 2);
    static constexpr size_t TBD = FEATS + ws_al((size_t)C::MA * C::D * 2);
    static constexpr size_t ROPE = TBD + ws_al((size_t)2 * C::BW * C::BW * 2);
    static constexpr size_t MODP = ROPE + ws_al((size_t)C::S * (C::AH / 2) * 8);
    static constexpr size_t END = MODP + ws_al((size_t)32 * C::DEPTH * (C::B + 1) * 6 * C::D * 4);
    static_assert((size_t)C::MA * C::HID * 2 <= (size_t)C::MA * C::PXW * 2, "U overlays PX");
    static_assert((size_t)C::MA * C::D * 4 <= 7 * PREP1, "MSUM overlays PREP");
    static_assert((size_t)C::MA * C::BW * 4 <= (size_t)C::MA * C::D * 2, "CVB overlays HX");
};
template <class C> struct CtxT {
    const float* const CONSTAS* in; float* out; unsigned char* ws;
    typedef WSM<C> W;
    HD const float* x() const { return in[0]; }
    HD const float* c() const { return in[1]; }
    HD const float* ctx() const { return in[2]; }
    HD const float* c_ctx() const { return in[3]; }
    HD const float* ada_w() const { return in[4]; }
    HD const float* ada_b() const { return in[5]; }
    HD const float* norm1_g() const { return in[6]; }
    HD const float* norm2_g() const { return in[7]; }
    HD const float* w_in() const { return in[8]; }
    HD const float* mu() const { return in[9]; }
    HD const float* w0() const { return in[10]; }
    HD const float* w_up() const { return in[11]; }
    HD const float* a0() const { return in[12]; }
    HD const float* a_up() const { return in[13]; }
    HD const float* k_k() const { return in[14]; }
    HD const float* k_a() const { return in[15]; }
    HD const float* r_k() const { return in[16]; }
    HD const float* g_up() const { return in[17]; }
    HD const float* lnx_g() const { return in[18]; }
    HD const float* lnx_b() const { return in[19]; }
    HD const float* sink() const { return in[20]; }
    HD const float* conv_dw() const { return in[21]; }
    HD const float* conv_dw_b() const { return in[22]; }
    HD const float* conv_ln_g() const { return in[23]; }
    HD const float* conv_ln_b() const { return in[24]; }
    HD const float* w_branch() const { return in[25]; }
    HD const float* w_out() const { return in[26]; }
    HD const float* w_mlp1() const { return in[27]; }
    HD const float* w_mlp2() const { return in[28]; }
    HD const float* final_g() const { return in[29]; }
    HD float* MOD() const { return (float*)(ws + W::MOD); }
    HD float* X() const { return (float*)(ws + W::X); }
    HD float* RSTD() const { return (float*)(ws + W::RSTD); }
    HD bf16* HX() const { return (bf16*)(ws + W::HX); }
    HD bf16* MIX() const { return (bf16*)(ws + W::HX); }
    HD float* CVB() const { return (float*)(ws + W::HX); }
    HD bf16* WinT() const { return (bf16*)(ws + W::WinT); }
    HD bf16* WbT() const { return (bf16*)(ws + W::WbT); }
    HD bf16* WoT() const { return (bf16*)(ws + W::WoT); }
    HD bf16* W1T() const { return (bf16*)(ws + W::W1T); }
    HD bf16* W2T() const { return (bf16*)(ws + W::W2T); }
    HD bf16* PX() const { return (bf16*)(ws + W::PX); }
    HD bf16* U() const { return (bf16*)(ws + W::PX); }
    HD float* PR() const { return (float*)(ws + W::PREP); }
    HD float* PW() const { return (float*)(ws + W::PREP + W::PREP1); }
    HD float* PK() const { return (float*)(ws + W::PREP + 2 * W::PREP1); }
    HD float* PV() const { return (float*)(ws + W::PREP + 3 * W::PREP1); }
    HD float* PKK() const { return (float*)(ws + W::PREP + 4 * W::PREP1); }
    HD float* PA() const { return (float*)(ws + W::PREP + 5 * W::PREP1); }
    HD float* Y() const { return (float*)(ws + W::PREP + 6 * W::PREP1); }
    HD float* MSUM() const { return (float*)(ws + W::PREP); }
    HD bf16* QR() const { return (bf16*)(ws + W::QR); }
    HD bf16* KR() const { return (bf16*)(ws + W::KR); }
    HD bf16* YT() const { return (bf16*)(ws + W::YT); }
    HD bf16* YTC() const { return (bf16*)(ws + W::YTC); }
    HD bf16* TX() const { return (bf16*)(ws + W::TX); }
    HD bf16* TC() const { return (bf16*)(ws + W::TC); }
    HD bf16* FEATS() const { return (bf16*)(ws + W::FEATS); }
    HD bf16* TBD() const { return (bf16*)(ws + W::TBD); }
    HD float* ROPE() const { return (float*)(ws + W::ROPE); }
    HD float* MODP() const { return (float*)(ws + W::MODP); }
};

template <class C> HD void row_info(int row, int& b, int& t, int& L, int& base, bool& isctx) {
    if (row < C::MX) { b = row / C::S; t = row % C::S; L = C::S; base = b * C::S; isctx = false; }
    else { const int r = row - C::MX; b = r / C::CT; t = r % C::CT; L = C::CT; base = C::MX + b * C::CT; isctx = true; }
}
template <class C> HD int mod_row(int row) { return row < C::MX ? row / C::S : C::B; }

template <class C> HD void el_xcopy(const CtxT<C>& c, long idx) {
    c.X()[idx] = idx < (long)C::MX * C::D ? c.x()[idx] : c.ctx()[idx - (long)C::MX * C::D];
}
template <class C> HD void el_dft_table(bf16* T, int L, long idx) {
    const int t = (int)(idx / (2 * L)), k = (int)(idx % (2 * L));
    const int kk = k < L ? k : k - L; const int m = (int)(((long)t * kk) % L);
    const float ang = 6.283185307179586f * (float)m / (float)L;
    const float v = (k < L ? cosf(ang) : sinf(ang)) / sqrtf((float)L * (float)C::FGW);
    T[idx] = f2bf(v);
}
template <class C> HD void el_mod(const CtxT<C>& c, long idx) {
    const int l = (int)(idx / (6 * C::D)), j = (int)(idx % (6 * C::D));
    float acc[C::B + 1];
#pragma unroll
    for (int r = 0; r <= C::B; ++r) acc[r] = 0.f;
    for (int k = 0; k < C::D; ++k) {
        const float w = c.ada_w()[((long)l * C::D + k) * 6 * C::D + j];
#pragma unroll
        for (int r = 0; r <= C::B; ++r) { const float cv = r < C::B ? c.c()[r * C::D + k] : c.c_ctx()[k]; acc[r] += cv * sigmoidf_(cv) * w; }
    }
    const float bb = c.ada_b()[l * 6 * C::D + j];
#pragma unroll
    for (int r = 0; r <= C::B; ++r) c.MOD()[((long)l * (C::B + 1) + r) * 6 * C::D + j] = acc[r] + bb;
}
HD void el_wt(bf16* dst, const float* src, int K, int Nsrc, long idx) { const int n = (int)(idx / K), k = (int)(idx % K); dst[idx] = n < Nsrc ? f2bf(src[(long)k * Nsrc + n]) : (bf16)0; }

template <class C> HD void el_rstd(const CtxT<C>& c, int row) {
    float s = 0.f; const float* xr = c.X() + (long)row * C::D;
    for (int j = 0; j < C::D; ++j) s += xr[j] * xr[j];
    c.RSTD()[row] = 1.0f / sqrtf(s / (float)C::D + 1e-6f);
}
template <class C> HD void el_hx(const CtxT<C>& c, int l, int which, long idx) {
    const int row = (int)(idx / C::D), j = (int)(idx % C::D);
    const float* m = c.MOD() + ((long)l * (C::B + 1) + mod_row<C>(row)) * 6 * C::D;
    const float g = (which ? c.norm2_g() : c.norm1_g())[l * C::D + j];
    const float sh = m[(which ? 3 : 0) * C::D + j], sc = m[(which ? 4 : 1) * C::D + j];
    c.HX()[idx] = f2bf(c.X()[idx] * c.RSTD()[row] * g * (1.0f + sc) + sh);
}
template <class Epi> HD void el_gemm4(const bf16* A, int lda, const bf16* Bt, int ldb, int N, int K, const Epi& epi, long idx) {
    const int row = (int)(idx / (N / 4)), col0 = (int)(idx % (N / 4)) * 4;
    float v[4] = {0.f, 0.f, 0.f, 0.f};
    const bf16* a = A + (long)row * lda;
    for (int k = 0; k < K; ++k) { const float av = bf2f(a[k]);
#pragma unroll
        for (int q = 0; q < 4; ++q) v[q] += av * bf2f(Bt[(long)(col0 + q) * ldb + k]); }
    epi(row, col0, v);
}
template <class C> struct EpiPX { const CtxT<C>* c;
    HD void operator()(int row, int col0, const float* v) const {
#pragma unroll
        for (int q = 0; q < 4; ++q) { const int col = col0 + q; float y = v[q]; if (col >= C::O_GATE) y = sigmoidf_(y); c->PX()[(long)row * C::PXW + col] = f2bf(y); } } };
template <class C> struct EpiMerge { const CtxT<C>* c; int i;
    HD void operator()(int row, int col0, const float* v) const {
#pragma unroll
        for (int q = 0; q < 4; ++q) { const int col = col0 + q; float y = v[q] * bf2f(c->PX()[(long)row * C::PXW + C::O_GATE + i * C::D + col]);
            const long o = (long)row * C::D + col; if (i > 0) y += c->MSUM()[o]; if (i < 3) c->MSUM()[o] = y; else c->MIX()[o] = f2bf(y); } } };
template <class C> struct EpiRes { const CtxT<C>* c; int l, gidx;
    HD void operator()(int row, int col0, const float* v) const {
        const float* m = c->MOD() + ((long)l * (C::B + 1) + mod_row<C>(row)) * 6 * C::D + gidx * C::D;
#pragma unroll
        for (int q = 0; q < 4; ++q) { const long o = (long)row * C::D + col0 + q; c->X()[o] += m[col0 + q] * v[q]; } } };
template <class C> struct EpiMlp1 { const CtxT<C>* c;
    HD void operator()(int row, int col0, const float* v) const {
#pragma unroll
        for (int q = 0; q < 4; ++q) { const float r = v[q] > 0.f ? v[q] : 0.f; c->U()[(long)row * C::HID + col0 + q] = f2bf(r * r); } } };
template <class C> struct EpiFno { const CtxT<C>* c; int L, row0;
    HD void operator()(int t, int col0, const float* v) const {
#pragma unroll
        for (int q = 0; q < 4; ++q) { const int col = col0 + q, b = col / C::BW, n = col % C::BW; c->FEATS()[(long)(row0 + b * L + t) * C::D + n] = f2bf(v[q]); } } };

template <class C> HD float shiftfeat(const CtxT<C>& c, int l, int d, int row, int prow, int i) {
    const int col = i < 3 * C::BW ? i : C::O_LORA + d * C::DLW + (i - 3 * C::BW);
    const float f = bf2f(c.PX()[(long)row * C::PXW + col]);
    const float fp = prow >= 0 ? bf2f(c.PX()[(long)prow * C::PXW + col]) : 0.f;
    return f + c.mu()[((long)l * 2 + d) * C::SHW + i] * (fp - f);
}
template <class C> HD void el_prep(const CtxT<C>& c, int l, long idx) {
    const int ch = (int)(idx % C::BW); const long t2 = idx / C::BW; const int row = (int)(t2 % C::MA), d = (int)(t2 / C::MA);
    int b, t, L, base; bool isc; row_info<C>(row, b, t, L, base, isc);
    const int prow = d == 0 ? (t > 0 ? row - 1 : -1) : (t < L - 1 ? row + 1 : -1);
    const float r = shiftfeat<C>(c, l, d, row, prow, ch), k = shiftfeat<C>(c, l, d, row, prow, C::BW + ch), v = shiftfeat<C>(c, l, d, row, prow, 2 * C::BW + ch);
    float wr = c.w0()[((long)l * 2 + d) * C::BW + ch], ar = c.a0()[((long)l * 2 + d) * C::BW + ch];
    for (int j = 0; j < C::DL; ++j) wr += tanhf(shiftfeat<C>(c, l, d, row, prow, 3 * C::BW + j)) * c.w_up()[(((long)l * 2 + d) * C::DL + j) * C::BW + ch];
    for (int j = 0; j < C::AL; ++j) ar += shiftfeat<C>(c, l, d, row, prow, 3 * C::BW + C::DL + j) * c.a_up()[(((long)l * 2 + d) * C::AL + j) * C::BW + ch];
    const float z = -wr; const float sp = (z > 0.f ? z : 0.f) + log1pf(expf(-fabsf(z)));
    const float decay = expf(-expf(-sp - 0.5f));
    const float a = sigmoidf_(ar);
    const int h = ch / C::RH; float ss = 0.f;
    for (int c2 = h * C::RH; c2 < (h + 1) * C::RH; ++c2) { const float kv = shiftfeat<C>(c, l, d, row, prow, C::BW + c2) * c.k_k()[l * C::BW + c2]; ss += kv * kv; }
    const float nrm = sqrtf(ss); const float kk = k * c.k_k()[l * C::BW + ch] / (nrm > 1e-12f ? nrm : 1e-12f);
    const float krep = k * (1.0f + (a - 1.0f) * c.k_a()[l * C::BW + ch]);
    const long o = ((long)d * C::MA + row) * C::BW + ch;
    c.PR()[o] = r; c.PW()[o] = decay; c.PK()[o] = krep; c.PV()[o] = v; c.PKK()[o] = kk; c.PA()[o] = a;
}
template <class C> HD void el_scan(const CtxT<C>& c, bool emit_ctx, long idx) {
    const int vr = (int)(idx % C::RH); long t2 = idx / C::RH; const int h = (int)(t2 % C::RNH); t2 /= C::RNH; const int b = (int)(t2 % C::B), d = (int)(t2 / C::B);
    float S[C::RH];
#pragma unroll
    for (int k = 0; k < C::RH; ++k) S[k] = 0.f;
    for (int ph = 0; ph < 2; ++ph) {
        const int L = ph == 0 ? C::CT : C::S, base = ph == 0 ? C::MX + b * C::CT : b * C::S; const bool emit = ph == 1 || emit_ctx;
        for (int i = 0; i < L; ++i) {
            const int t = d == 0 ? i : L - 1 - i; const long off = ((long)d * C::MA + base + t) * C::BW + h * C::RH;
            float sa = 0.f;
#pragma unroll
            for (int k = 0; k < C::RH; ++k) sa -= S[k] * c.PKK()[off + k];
            const float vv = c.PV()[off + vr]; float y = 0.f;
#pragma unroll
            for (int k = 0; k < C::RH; ++k) { S[k] = S[k] * c.PW()[off + k] + sa * (c.PKK()[off + k] * c.PA()[off + k]) + vv * c.PK()[off + k]; y += S[k] * c.PR()[off + k]; }
            if (emit) c.Y()[off + vr] = y;
        }
    }
}
template <class C> HD void el_readout(const CtxT<C>& c, int l, long idx) {
    const int row = (int)(idx / C::BW), ch = (int)(idx % C::BW), h = ch / C::RH;
    const long o0 = (long)row * C::BW + h * C::RH, o1 = ((long)C::MA + row) * C::BW + h * C::RH;
    float mean = 0.f;
    for (int k = 0; k < C::RH; ++k) mean += c.Y()[o0 + k] + c.Y()[o1 + k];
    mean /= (float)C::RH; float var = 0.f;
    for (int k = 0; k < C::RH; ++k) { const float dv = c.Y()[o0 + k] + c.Y()[o1 + k] - mean; var += dv * dv; }
    var /= (float)C::RH;
    const float y = c.Y()[o0 + ch - h * C::RH] + c.Y()[o1 + ch - h * C::RH];
    const float yn = (y - mean) / sqrtf(var + 64e-5f) * c.lnx_g()[l * C::BW + ch] + c.lnx_b()[l * C::BW + ch];
    float bonus = 0.f;
    for (int d = 0; d < 2; ++d) { const long od = d == 0 ? o0 : o1; float s = 0.f;
        for (int k = 0; k < C::RH; ++k) s += c.PR()[od + k] * c.PK()[od + k] * c.r_k()[(((long)l * 2 + d) * C::RNH + h) * C::RH + k];
        bonus += s * c.PV()[od + ch - h * C::RH]; }
    float g = 0.f;
    for (int j = 0; j < C::GL; ++j) g += sigmoidf_(bf2f(c.PX()[(long)row * C::PXW + C::O_G + j])) * c.g_up()[((long)l * C::GL + j) * C::BW + ch];
    c.FEATS()[(long)row * C::D + 1 * C::BW + ch] = f2bf((yn + bonus) * g);
}
template <class C> HD float rope_el(const bf16* src, int dd, int t, bool rot) {
    const float u = bf2f(src[dd]); if (!rot) return u;
    constexpr int hs = C::AH / 2, nf = hs / 2;
    const int half = dd / hs, dp = dd % hs, i = dp % nf; const bool first = dp < nf;
    const int pos = half == 0 ? t / C::GW : t % C::GW;
    const float inv = powf(10000.0f, -(float)i / (float)nf), ang = (float)pos * inv, cs = cosf(ang), sn = sinf(ang);
    const float p = bf2f(src[first ? dd + nf : dd - nf]);
    return first ? u * cs - p * sn : u * cs + p * sn;
}
template <class C> HD void el_rope(const CtxT<C>& c, long idx) {
    const int row = (int)(idx / (C::BW + C::AKVW)), j = (int)(idx % (C::BW + C::AKVW));
    int b, t, L, base; bool isc; row_info<C>(row, b, t, L, base, isc);
    if (j < C::BW) { const int h = j / C::AH, dd = j % C::AH; c.QR()[(long)row * C::BW + j] = f2bf(rope_el<C>(c.PX() + (long)row * C::PXW + C::O_Q + h * C::AH, dd, t, !isc)); }
    else { const int j2 = j - C::BW, g = j2 / C::AH, dd = j2 % C::AH; c.KR()[(long)row * C::AKVW + j2] = f2bf(rope_el<C>(c.PX() + (long)row * C::PXW + C::O_KV + g * C::AH, dd, t, !isc)); }
}
template <class C> HD void el_attn(const CtxT<C>& c, int l, long idx) {
    const int row = (int)(idx / C::ANH), h = (int)(idx % C::ANH), g = h / C::AREP;
    int b, t, L, base; bool isc; row_info<C>(row, b, t, L, base, isc);
    float q[C::AH], acc[C::AH];
#pragma unroll
    for (int dd = 0; dd < C::AH; ++dd) { q[dd] = bf2f(c.QR()[(long)row * C::BW + h * C::AH + dd]); acc[dd] = 0.f; }
    const float scale = 1.0f / sqrtf((float)C::AH);
    float m = c.sink()[l * C::ANH + h], den = 1.0f;
    const int nloc = isc ? 0 : 2 * C::WIN + 1;
    for (int jj = 0; jj < nloc + C::CT; ++jj) {
        int krow;
        if (jj < nloc) { const int j = t - C::WIN + jj; if (j < 0 || j >= L) continue; krow = base + j; }
        else krow = C::MX + b * C::CT + (jj - nloc);
        const bf16* kp = c.KR() + (long)krow * C::AKVW + g * C::AH; float s = 0.f;
#pragma unroll
        for (int dd = 0; dd < C::AH; ++dd) s += q[dd] * bf2f(kp[dd]);
        s *= scale;
        const float mn = s > m ? s : m, f = expf(m - mn), p = expf(s - mn);
        const bf16* vp = c.PX() + (long)krow * C::PXW + C::O_KV + C::AKVW + g * C::AH;
        den = den * f + p;
#pragma unroll
        for (int dd = 0; dd < C::AH; ++dd) acc[dd] = acc[dd] * f + p * bf2f(vp[dd]);
        m = mn;
    }
#pragma unroll
    for (int dd = 0; dd < C::AH; ++dd) c.FEATS()[(long)row * C::D + 2 * C::BW + h * C::AH + dd] = f2bf(acc[dd] / den);
}
template <class C> HD void el_fnoA(const CtxT<C>& c, long idx) {
    const int row = (int)(idx / C::BW), n = (int)(idx % C::BW), g = n / C::FGW, cf = n % C::FGW;
    int b, t, L, base; bool isc; row_info<C>(row, b, t, L, base, isc);
    float ar = 0.f, ai = 0.f;
    for (int cp = 0; cp < C::FGW; ++cp) { const float u = bf2f(c.PX()[(long)row * C::PXW + C::O_FNO + g * C::FGW + cp]);
        const float ang = 6.283185307179586f * (float)((cf * cp) % C::FGW) / (float)C::FGW; ar += u * cosf(ang); ai -= u * sinf(ang); }
    bf16* yt = (isc ? c.YTC() : c.YT()) + ((long)b * C::BW + n) * 2 * L;
    yt[t] = f2bf(ar); yt[L + t] = f2bf(ai);
}
template <class C> HD void el_conv(const CtxT<C>& c, int l, long idx) {
    const int row = (int)(idx / C::BW), ch = (int)(idx % C::BW);
    int b, t, L, base; bool isc; row_info<C>(row, b, t, L, base, isc);
    float s = c.conv_dw_b()[l * C::BW + ch];
    for (int j = 0; j < C::CK; ++j) { const int tt = t + j - (C::CK - 1) / 2; if (tt < 0 || tt >= L) continue;
        const bf16* p = c.PX() + (long)(base + tt) * C::PXW + C::O_CONV;
        s += bf2f(p[ch]) * sigmoidf_(bf2f(p[C::BW + ch])) * c.conv_dw()[((long)l * C::CK + j) * C::BW + ch]; }
    c.CVB()[idx] = s;
}
template <class C> HD void el_convln(const CtxT<C>& c, int l, int row) {
    const float* v = c.CVB() + (long)row * C::BW; float mean = 0.f;
    for (int k = 0; k < C::BW; ++k) mean += v[k];
    mean /= (float)C::BW; float var = 0.f;
    for (int k = 0; k < C::BW; ++k) { const float dv = v[k] - mean; var += dv * dv; }
    var /= (float)C::BW; const float rs = 1.0f / sqrtf(var + 1e-5f);
    for (int k = 0; k < C::BW; ++k) { const float y = (v[k] - mean) * rs * c.conv_ln_g()[l * C::BW + k] + c.conv_ln_b()[l * C::BW + k]; c.FEATS()[(long)row * C::D + 3 * C::BW + k] = f2bf(y * sigmoidf_(y)); }
}
template <class C> HD void el_final(const CtxT<C>& c, int row) {
    float s = 0.f; const float* xr = c.X() + (long)row * C::D;
    for (int j = 0; j < C::D; ++j) s += xr[j] * xr[j];
    const float rs = 1.0f / sqrtf(s / (float)C::D + 1e-6f);
    for (int j = 0; j < C::D; ++j) c.out[(long)row * C::D + j] = xr[j] * rs * c.final_g()[j];
}
typedef CfgFull C;
#ifndef PROBE
#define PROBE -1
#endif
#define RP(k) for (int rp_ = 0; rp_ < ((PROBE) == (k) ? 2 : 1); ++rp_)
#ifndef GEMM_MASK
#define GEMM_MASK 0xFF
#endif
#ifndef EN_ALL
#define EN_ALL 1
#endif
#ifndef EN_GEMM
#define EN_GEMM EN_ALL
#endif
#ifndef EN_EL_XCOPY
#define EN_EL_XCOPY EN_ALL
#endif
#ifndef EN_EL_DFT_TABLE
#define EN_EL_DFT_TABLE EN_ALL
#endif
#ifndef EN_EL_MOD
#define EN_EL_MOD EN_ALL
#endif
#ifndef EN_MISC
#define EN_MISC EN_ALL
#endif
#ifndef EN_EL_HX
#define EN_EL_HX EN_ALL
#endif
#ifndef EN_EL_PREP
#define EN_EL_PREP EN_ALL
#endif
#ifndef EN_EL_ROPE
#define EN_EL_ROPE EN_ALL
#endif
#ifndef EN_EL_FNOA
#define EN_EL_FNOA EN_ALL
#endif
#ifndef EN_EL_CONV
#define EN_EL_CONV EN_ALL
#endif
#ifndef EN_EL_SCAN
#define EN_EL_SCAN EN_ALL
#endif
#ifndef EN_EL_ATTN
#define EN_EL_ATTN EN_ALL
#endif
#ifndef EN_EL_CONVLN
#define EN_EL_CONVLN EN_ALL
#endif
#ifndef EN_EL_READOUT
#define EN_EL_READOUT EN_ALL
#endif
#define GAS __attribute__((address_space(1)))
#define LAS __attribute__((address_space(3)))
typedef unsigned v4u __attribute__((ext_vector_type(4)));
typedef float f32x4 __attribute__((ext_vector_type(4)));
typedef short bf16x8 __attribute__((ext_vector_type(8)));
typedef GAS unsigned gu32;
#define RLX_AGENT __ATOMIC_RELAXED, __HIP_MEMORY_SCOPE_AGENT
#define LDS_WAIT() asm volatile("s_waitcnt lgkmcnt(0)" ::: "memory")

typedef WSM<C> WSMap;
typedef CtxT<C> Ctx;

namespace pg8 {
constexpr int BM = 256, BK = 64, HALF = 128, HTB = HALF * BK * 2, STAGE_BYTES = 8 * HTB;
__host__ __device__ __forceinline__ int lds_byte(int r, int c) { const int st = (r >> 4) * 2 + (c >> 5), rr = r & 15, cc = c & 31, ob = rr * 64 + cc * 2; return st * 1024 + (ob ^ (((ob >> 9) & 1) << 5)); }
__host__ __device__ __forceinline__ void stage_rc(int b, int& R, int& Cc) { const int st = b / 1024, sb = b % 1024, swz = sb ^ (((sb >> 9) & 1) << 5); R = (st >> 1) * 16 + swz / 64; Cc = (st & 1) * 32 + (swz % 64) / 2; }
__host__ __device__ __forceinline__ int perm32(int rho) { const int n = rho >> 4, i = rho & 15; return 8 * (i >> 2) + 4 * n + (i & 3); }
struct Unit { int pm, pn, tag; long aoff, boff; };
struct Gemm { const bf16* A; const bf16* Bt; int lda, ldb, K; };

template <class Epi, class Sched>
__device__ __forceinline__ void gemm_phase(LAS unsigned char* lds, const Gemm g, const Sched& S, const Epi& E, const int tid) {
    const int wid = __builtin_amdgcn_readfirstlane(tid >> 6), lane = tid & 63, wr = wid >> 2, wc = wid & 3, fr = lane & 15, fq = lane >> 4;
    const int K = g.K, nt = K / BK;
    unsigned voffA[2], voffB[2];
#pragma unroll
    for (int i = 0; i < 2; ++i) { int R, Cc; stage_rc(tid * 16 + i * 8192, R, Cc); const int Rb = (R & ~31) + perm32(R & 31); voffA[i] = (unsigned)(R * g.lda + Cc) * 2u; voffB[i] = (unsigned)(Rb * g.ldb + Cc) * 2u; }
    const size_t kstep = (size_t)(BK * 2);
    const size_t hstepA = (size_t)HALF * g.lda * 2, hstepB = (size_t)HALF * g.ldb * 2;
    const unsigned ldsw = (unsigned)wid * 1024u;
    const int aoff = lds_byte(wr * 64 + fr, fq * 8), boff = lds_byte(wc * 32 + fr, fq * 8);
#define PG8_SA(b, h) (((b) * 2 + (h)) * HTB)
#define PG8_SB(b, h) ((4 + (b) * 2 + (h)) * HTB)
#define PG8_STAGE(bufoff, gbase, voff) do { _Pragma("unroll") for (int _i = 0; _i < 2; ++_i) \
        __builtin_amdgcn_global_load_lds((const unsigned*)((const char*)(gbase) + (voff)[_i]), (LAS unsigned*)(lds + (bufoff) + ldsw + _i * 8192), 16, 0, 0); } while (0)
#define PG8_LDA(dst, b, h) do { _Pragma("unroll") for (int m = 0; m < 4; ++m) _Pragma("unroll") for (int k = 0; k < 2; ++k) dst[m][k] = *(const LAS bf16x8*)(lds + PG8_SA(b, h) + aoff + m * 2048 + k * 1024); } while (0)
#define PG8_LDB(dst, b, h) do { _Pragma("unroll") for (int n = 0; n < 2; ++n) _Pragma("unroll") for (int k = 0; k < 2; ++k) dst[n][k] = *(const LAS bf16x8*)(lds + PG8_SB(b, h) + boff + n * 2048 + k * 1024); } while (0)
#define PG8_MMA(ai, bj, At, Bt) do { __builtin_amdgcn_s_setprio(1); _Pragma("unroll") for (int m = 0; m < 4; ++m) _Pragma("unroll") for (int n = 0; n < 2; ++n) _Pragma("unroll") for (int k = 0; k < 2; ++k) \
        acc[ai][bj][m][n] = __builtin_amdgcn_mfma_f32_16x16x32_bf16(Bt[n][k], At[m][k], acc[ai][bj][m][n], 0, 0, 0); __builtin_amdgcn_s_setprio(0); } while (0)
#define PG8_WAIT_V(n) asm volatile("s_waitcnt vmcnt(" #n ")" ::: "memory")
#define PG8_WAIT_L(n) asm volatile("s_waitcnt lgkmcnt(" #n ")" ::: "memory")
#define PG8_BAR __builtin_amdgcn_s_barrier()
#define PG8_SCHED __builtin_amdgcn_sched_barrier(0)
    Unit cur, nxt; int ui = 0;
    if (!S.next(0, cur)) return;
    f32x4 acc[2][2][4][2];
#pragma unroll
    for (int a = 0; a < 2; ++a)
#pragma unroll
        for (int b = 0; b < 2; ++b)
#pragma unroll
            for (int m = 0; m < 4; ++m)
#pragma unroll
                for (int n = 0; n < 2; ++n) acc[a][b][m][n] = (f32x4){0.f, 0.f, 0.f, 0.f};
    bf16x8 At[4][2], B0[2][2], B1[2][2];
    const char* cA = (const char*)g.A + cur.aoff; const char* cB = (const char*)g.Bt + cur.boff;
    PG8_STAGE(PG8_SB(0, 0), cB, voffB); PG8_STAGE(PG8_SB(0, 1), cB + hstepB, voffB); PG8_STAGE(PG8_SA(0, 0), cA, voffA); PG8_STAGE(PG8_SA(0, 1), cA + hstepA, voffA);
    if (wr == 1) PG8_BAR;
    PG8_WAIT_V(2); PG8_BAR;
    PG8_STAGE(PG8_SB(1, 0), cB + kstep, voffB); PG8_STAGE(PG8_SA(1, 0), cA + kstep, voffA); PG8_STAGE(PG8_SB(1, 1), cB + hstepB + kstep, voffB);
    PG8_WAIT_V(6); PG8_BAR;
    for (;;) {
        const bool has_next = S.next(ui + 1, nxt);
        const char* nA = has_next ? (const char*)g.A + nxt.aoff : cA; const char* nB = has_next ? (const char*)g.Bt + nxt.boff : cB;
        for (int t = 0; t < nt; t += 2) {
            const bool last = (t == nt - 2);
            const char* a1 = cA + (size_t)(t + 1) * kstep;
            const char* a2 = last ? nA : cA + (size_t)(t + 2) * kstep; const char* b2 = last ? nB : cB + (size_t)(t + 2) * kstep;
            const char* a3 = a2 + kstep; const char* b3 = b2 + kstep;
            PG8_LDB(B0, 0, 0); PG8_LDB(B1, 0, 1); PG8_SCHED; PG8_LDA(At, 0, 0); PG8_STAGE(PG8_SA(1, 1), a1 + hstepA, voffA);
            PG8_WAIT_V(8); PG8_WAIT_L(0); PG8_BAR; PG8_MMA(0, 0, At, B0); PG8_MMA(0, 1, At, B1); PG8_BAR; PG8_SCHED;
            PG8_LDA(At, 0, 1); PG8_STAGE(PG8_SB(0, 0), b2, voffB); PG8_STAGE(PG8_SB(0, 1), b2 + hstepB, voffB); PG8_STAGE(PG8_SA(0, 0), a2, voffA);
            PG8_WAIT_V(8); PG8_WAIT_L(0); PG8_BAR; PG8_MMA(1, 0, At, B0); PG8_MMA(1, 1, At, B1); PG8_BAR; PG8_SCHED;
            PG8_LDB(B0, 1, 0); PG8_LDB(B1, 1, 1); PG8_SCHED; PG8_LDA(At, 1, 0); PG8_STAGE(PG8_SA(0, 1), a2 + hstepA, voffA);
            PG8_WAIT_V(8); PG8_WAIT_L(0); PG8_BAR; PG8_MMA(0, 0, At, B0); PG8_MMA(0, 1, At, B1); PG8_BAR; PG8_SCHED;
            PG8_LDA(At, 1, 1); PG8_STAGE(PG8_SB(1, 0), b3, voffB); PG8_STAGE(PG8_SB(1, 1), b3 + hstepB, voffB); PG8_STAGE(PG8_SA(1, 0), a3, voffA);
            PG8_WAIT_V(8); PG8_WAIT_L(0); PG8_BAR; PG8_MMA(1, 0, At, B0); PG8_MMA(1, 1, At, B1); PG8_BAR; PG8_SCHED;
        }
        if (wr == 0) PG8_BAR;
        const bool zero_acc = E(acc, cur, wr, wc, fr, fq);
        if (!has_next) break;
        if (zero_acc)
#pragma unroll
        for (int a = 0; a < 2; ++a)
#pragma unroll
            for (int b = 0; b < 2; ++b)
#pragma unroll
                for (int m = 0; m < 4; ++m)
#pragma unroll
                    for (int n = 0; n < 2; ++n) acc[a][b][m][n] = (f32x4){0.f, 0.f, 0.f, 0.f};
        cur = nxt; cA = nA; cB = nB; ++ui;
        if (wr == 1) PG8_BAR;
    }
    PG8_WAIT_V(0);
    PG8_BAR;
#undef PG8_SA
#undef PG8_SB
#undef PG8_STAGE
#undef PG8_LDA
#undef PG8_LDB
#undef PG8_MMA
#undef PG8_WAIT_V
#undef PG8_WAIT_L
#undef PG8_BAR
#undef PG8_SCHED
}
template <class E4> struct EpiWrap { E4 e;
    __device__ __forceinline__ void operator()(const f32x4 (&acc)[2][2][4][2], const Unit& u, int wr, int wc, int fr, int fq) const {
#pragma unroll
        for (int ai = 0; ai < 2; ++ai)
#pragma unroll
            for (int m = 0; m < 4; ++m)
#pragma unroll
                for (int bj = 0; bj < 2; ++bj)
#pragma unroll
                    for (int n = 0; n < 2; ++n) { const int row = u.pm * 256 + ai * 128 + wr * 64 + m * 16 + fr, col0 = u.pn * 256 + bj * 128 + wc * 32 + fq * 8 + n * 4;
                        const f32x4 a = acc[ai][bj][m][n]; const float v[4] = {a[0], a[1], a[2], a[3]}; e(u, row, col0, v); }
    }
};
struct RectSched {
    int G, c, nbr; int pm0_0, nM_0, pn0_0, nN_0, pm0_1, nM_1, pn0_1, nN_1; long lda2, ldb2, abr, bbr;
    bool blocked = false; int bm = 4, bn = 8;
    __device__ __forceinline__ bool next(int i, Unit& u) const {
        const int round = (nbr == 1) ? i : (i >> 2), br = (nbr == 1) ? 0 : (i & 3); int L = round * G + c;
        const int n0 = nM_0 * nN_0, n1 = nM_1 * nN_1;
        bool r = false; if (L >= n0) { L -= n0; r = true; if (L >= n1) return false; }
        const unsigned nm = (unsigned)(r ? nM_1 : nM_0); unsigned q = (unsigned)L / nm, rem = (unsigned)L - q * nm;
        const unsigned nn_ = (unsigned)nN_0; int bm_ = bm, bn_ = bn; if (nm % (unsigned)bm_ || nn_ % (unsigned)bn_) { bm_ = 4; bn_ = 8; }
        if (blocked && !r && nm % (unsigned)bm_ == 0 && nn_ % (unsigned)bn_ == 0) { const int bm = bm_, bn = bn_; const unsigned bsz = (unsigned)(bm * bn), blk = (unsigned)L / bsz, w = (unsigned)L - blk * bsz, nbm = nm / (unsigned)bm, bq = blk / nbm, br_ = blk - bq * nbm, wq = w / (unsigned)bm; rem = br_ * bm + (w - wq * bm); q = bq * bn + wq; }
        u.pm = (r ? pm0_1 : pm0_0) + (int)rem; u.pn = (r ? pn0_1 : pn0_0) + (int)q; u.tag = br;
        u.aoff = (long)u.pm * 256 * lda2 + br * abr; u.boff = (long)u.pn * 256 * ldb2 + br * bbr; return true;
    }
};
struct ChainSched {
    int G, c, nM, ntl, nsl, per; long lda2, ldb2, ksl;
    __device__ __forceinline__ bool next(int i, Unit& u) const {
        if (i >= per) return false;
        const unsigned q = (unsigned)(c * per + i), tile = q / (unsigned)nsl, sl = q - tile * (unsigned)nsl; if ((int)tile >= ntl) return false;
        const unsigned pn = tile / (unsigned)nM, pm = tile - pn * (unsigned)nM;
        u.pm = (int)pm; u.pn = (int)pn; u.aoff = (long)pm * 256 * lda2 + sl * ksl; u.boff = (long)pn * 256 * ldb2 + sl * ksl;
        const bool tile_end = (int)sl == nsl - 1, end = tile_end || i == per - 1, from0 = (int)(tile * (unsigned)nsl) >= c * per;
        u.tag = !end ? 0 : (from0 && tile_end) ? 1 : tile_end ? 2 : 3; return true;
    }
};
}

#define XB_TMO      128
#define XB_XCNT(j)  (256  + 64 * (j))
#define XB_XSUB(j)  (1280 + 64 * (j))
#define XB_XGEN(j)  (2304 + 64 * (j))
#define XB_TOP      3328
#define XB_TOPGEN   3392
#define XCD_BAR_WORDS 3456
#define XB_SPIN_CAP (1u << 18)
__device__ __forceinline__ unsigned xb_ld(unsigned* p)              { return __hip_atomic_load(p, __ATOMIC_RELAXED, __HIP_MEMORY_SCOPE_AGENT); }
__device__ __forceinline__ unsigned xb_add(unsigned* p, unsigned v) { return __hip_atomic_fetch_add(p, v, __ATOMIC_RELAXED, __HIP_MEMORY_SCOPE_AGENT); }
__device__ __forceinline__ unsigned xb_xcc_id() { return (unsigned)__builtin_amdgcn_s_getreg((3 << 11) | 20) & 0xFu; }
#define XB_SPIN(cond, bar) do { unsigned _sp = 0; while (cond) { __builtin_amdgcn_s_sleep(1); \
    if ((++_sp & 255u) == 0u) { if (xb_ld(&(bar)[XB_TMO])) break; if (_sp > XB_SPIN_CAP) { atomicAdd(&(bar)[XB_TMO], 1u); break; } } } } while (0)
struct XcdBarrier { unsigned* bar; unsigned x; volatile LAS unsigned* st; unsigned members; };
__device__ __forceinline__ XcdBarrier xcd_barrier_post(unsigned* bar, volatile LAS unsigned* st, unsigned members, bool member) {
    XcdBarrier b; b.bar = bar; b.x = xb_xcc_id(); b.st = st; b.members = members;
    if (!member) return b;
    if (threadIdx.x == 0) (void)xb_add(&bar[XB_XCNT(b.x)], 1u);
    return b;
}
__device__ __forceinline__ void xcd_barrier_complete(unsigned* bar, unsigned x, unsigned G, unsigned& nloc, unsigned& nx) {
    unsigned sum, cnt, mine, sp = 0u;
    for (;;) {
        sum = 0u; cnt = 0u; mine = 0u;
#pragma unroll
        for (unsigned j = 0; j < 16; ++j) { const unsigned c = xb_ld(&bar[XB_XCNT(j)]); sum += c; cnt += (c > 0u) ? 1u : 0u; mine = (j == x) ? c : mine; }
        if (sum == G) break;
        __builtin_amdgcn_s_sleep(1);
        if ((++sp & 255u) == 0u) { if (xb_ld(&bar[XB_TMO])) break; if (sp > XB_SPIN_CAP) { atomicAdd(&bar[XB_TMO], 1u); break; } }
    }
    nloc = mine > 0u ? mine : 1u; nx = cnt > 0u ? cnt : 1u;
}
__device__ __forceinline__ void xcd_barrier(const XcdBarrier& b) {
    asm volatile("s_waitcnt vmcnt(0)" ::: "memory");
    __syncthreads();
    if (threadIdx.x == 0) {
        unsigned* bar = b.bar; unsigned bx_ = b.x; asm volatile("" : "+s"(bx_));
        __builtin_amdgcn_s_waitcnt(0);
        unsigned nloc = b.st[0], nx = b.st[1];
        if (nloc == 0u) { xcd_barrier_complete(bar, bx_, b.members, nloc, nx); b.st[0] = nloc; b.st[1] = nx; }
        const unsigned old = xb_add(&bar[XB_XSUB(bx_)], 1u);
        const unsigned gen = old / nloc;
        if (old + 1u == (gen + 1u) * nloc) {
            __builtin_amdgcn_fence(__ATOMIC_RELEASE, "agent");
            asm volatile("s_waitcnt vmcnt(0)" ::: "memory");
            const unsigned og = xb_add(&bar[XB_TOP], 1u);
            const unsigned tg = og / nx;
            if (og + 1u == (tg + 1u) * nx) xb_add(&bar[XB_TOPGEN], 1u);
            else XB_SPIN(xb_ld(&bar[XB_TOPGEN]) == tg, bar);
            __builtin_amdgcn_fence(__ATOMIC_ACQUIRE, "agent");
            xb_add(&bar[XB_XGEN(bx_)], 1u);
            asm volatile("s_waitcnt vmcnt(0)" ::: "memory");
        } else {
            XB_SPIN(xb_ld(&bar[XB_XGEN(bx_)]) == gen, bar);
            __builtin_amdgcn_fence(__ATOMIC_ACQUIRE, "agent");
            asm volatile("s_waitcnt vmcnt(0)" ::: "memory");
        }
    }
    __syncthreads();
}

constexpr int NWAVES = 8, NTHR = 512;
constexpr int RING_BYTES = 131072, LDSCTL_OFF = RING_BYTES, MISC_OFF = LDSCTL_OFF + 320, LDS_BYTES = 147456;
constexpr int CW_BAR = 4096, CW_FLAGS = 16384, FLAG_BANK = 288 * 64;

__device__ __forceinline__ unsigned pk2(float lo, float hi) { return (unsigned)f2bf(lo) | ((unsigned)f2bf(hi) << 16); }
__device__ __forceinline__ void transpose_item(const float* W, int K, int N, bf16* WT, int row_off, LAS float* scr, int item, int lane) {
    const int nblk = N / 32, kb = item / nblk, nb = item % nblk, k0 = 64 * kb, n0 = 32 * nb;
#pragma unroll 8
    for (int i = 0; i < 32; ++i) { const int kk = 2 * i + (lane >> 5); scr[kk * 33 + (lane & 31)] = W[(size_t)(k0 + kk) * N + n0 + (lane & 31)]; }
    LDS_WAIT(); asm volatile("" ::: "memory");
    const int c = lane & 7;
#pragma unroll
    for (int j = 0; j < 4; ++j) { const int n = (lane >> 3) + 8 * j; const LAS float* s = scr + (8 * c) * 33 + n;
        v4u o; o.x = pk2(s[0 * 33], s[1 * 33]); o.y = pk2(s[2 * 33], s[3 * 33]); o.z = pk2(s[4 * 33], s[5 * 33]); o.w = pk2(s[6 * 33], s[7 * 33]);
        *(GAS v4u*)(WT + (size_t)(row_off + n0 + n) * K + k0 + 8 * c) = o; }
    LDS_WAIT(); asm volatile("" ::: "memory");
}
__device__ __forceinline__ void transpose_item64(const float* W, int K, int N, bf16* WT, LAS float* scr, int item, int lane) {
    const int nblk = N / 64, kb = item / nblk, nb = item - kb * nblk, k0 = 64 * kb, n0 = 64 * nb;
    const float* src = W + (size_t)(k0 + (lane >> 4)) * N + n0 + (lane & 15) * 4;
    f32x4 v[16];
#pragma unroll
    for (int i = 0; i < 16; ++i) v[i] = *(const f32x4*)(src + (size_t)(4 * i) * N);
#pragma unroll
    for (int i = 0; i < 16; ++i) { const int kk = 4 * i + (lane >> 4); *(LAS f32x4*)(scr + kk * 64 + (((lane & 15) * 4 + 4 * (kk >> 3)) & 63)) = v[i]; }
    LDS_WAIT(); asm volatile("" ::: "memory");
    const int c = lane & 7;
#pragma unroll
    for (int j = 0; j < 8; ++j) { const int n = (lane >> 3) + 8 * j; const LAS float* s = scr + (8 * c) * 64 + ((n + 4 * c) & 63);
        v4u o; o.x = pk2(s[0 * 64], s[1 * 64]); o.y = pk2(s[2 * 64], s[3 * 64]); o.z = pk2(s[4 * 64], s[5 * 64]); o.w = pk2(s[6 * 64], s[7 * 64]);
        *(GAS v4u*)(WT + (size_t)(n0 + n) * K + k0 + 8 * c) = o; }
    LDS_WAIT(); asm volatile("" ::: "memory");
}
__device__ __forceinline__ float wave_sum(float v) {
#pragma unroll
    for (int o = 1; o < 64; o <<= 1) v += __shfl_xor(v, o);
    return v;
}

typedef float f32x2_t __attribute__((ext_vector_type(2))); typedef __bf16 bf16x2_t __attribute__((ext_vector_type(2)));
typedef unsigned u32x2 __attribute__((ext_vector_type(2)));
__device__ __forceinline__ unsigned cvtpk(float lo, float hi) { f32x2_t v = {lo, hi}; bf16x2_t b = __builtin_convertvector(v, bf16x2_t); return __builtin_bit_cast(unsigned, b); }
__device__ __forceinline__ float fast_sigmoid(float x) { return __builtin_amdgcn_rcpf(1.0f + __builtin_amdgcn_exp2f(-1.4426950408889634f * x)); }
__device__ __forceinline__ float fexp(float x) { return __builtin_amdgcn_exp2f(x * 1.4426950408889634f); }
__device__ __forceinline__ float flog(float x) { return __builtin_amdgcn_logf(x) * 0.6931471805599453f; }
__device__ __forceinline__ float ftanh(float x) { return 1.0f - 2.0f * __builtin_amdgcn_rcpf(1.0f + fexp(2.0f * x)); }
__device__ __forceinline__ float bflo(unsigned w) { return __builtin_bit_cast(float, w << 16); }
__device__ __forceinline__ float bfhi(unsigned w) { return __builtin_bit_cast(float, w & 0xffff0000u); }
#define EPI_LOOP(...) \
    _Pragma("unroll") for (int ai = 0; ai < 2; ++ai) _Pragma("unroll") for (int m = 0; m < 4; ++m) { const int row = u.pm * 256 + ai * 128 + wr * 64 + m * 16 + fr; \
        _Pragma("unroll") for (int bj = 0; bj < 2; ++bj) _Pragma("unroll") for (int n = 0; n < 2; ++n) { const int col0 = u.pn * 256 + bj * 128 + wc * 32 + fq * 8 + n * 4; f32x4 v = acc[ai][bj][m][n]; __VA_ARGS__ } \
        asm volatile("" ::: "memory"); }
#define EPI_LOOP8(...) \
    _Pragma("unroll") for (int ai = 0; ai < 2; ++ai) _Pragma("unroll") for (int m = 0; m < 4; ++m) { const int row = u.pm * 256 + ai * 128 + wr * 64 + m * 16 + fr; \
        _Pragma("unroll") for (int bj = 0; bj < 2; ++bj) { const int col0 = u.pn * 256 + bj * 128 + wc * 32 + fq * 8; f32x4 v0 = acc[ai][bj][m][0], v1 = acc[ai][bj][m][1]; __VA_ARGS__ } \
        asm volatile("" ::: "memory"); }
struct DEpiPX { bf16* PX; const float* ROPE; bf16* KR;
    __device__ __forceinline__ bool operator()(f32x4 (&acc)[2][2][4][2], const pg8::Unit& u, int wr, int wc, int fr, int fq) const {
        const bool lat = u.pm * 256 < C::MX;
        EPI_LOOP8({ if (col0 >= C::O_GATE) {
                _Pragma("unroll") for (int e = 0; e < 4; ++e) { v0[e] = fmaxf(fast_sigmoid(v0[e]), 1e-6f); v1[e] = fmaxf(fast_sigmoid(v1[e]), 1e-6f); } }
            else if (lat && ((col0 >= C::O_KV && col0 < C::O_KV + C::AKVW) || (col0 >= C::O_Q && col0 < C::O_Q + C::BW))) {
                const int d = (col0 - (col0 >= C::O_Q ? C::O_Q : C::O_KV)) & (C::AH - 1), half = d >> 5, dp = d & 31, i0 = dp & 15; const bool first = dp < 16;
                const float* rp = ROPE + ((size_t)(row % C::S) * (C::AH / 2) + half * (C::AH / 4) + i0) * 2;
                const f32x4 c0 = *(const f32x4*)(rp), c1 = *(const f32x4*)(rp + 4), c2 = *(const f32x4*)(rp + 8), c3 = *(const f32x4*)(rp + 12);
                f32x4 p0, p1;
                _Pragma("unroll") for (int e = 0; e < 4; ++e) { p0[e] = __shfl_xor(v0[e], 32); p1[e] = __shfl_xor(v1[e], 32); }
                const float sg = first ? -1.0f : 1.0f;
                v0[0] = v0[0] * c0[0] + sg * p0[0] * c0[1]; v0[1] = v0[1] * c0[2] + sg * p0[1] * c0[3]; v0[2] = v0[2] * c1[0] + sg * p0[2] * c1[1]; v0[3] = v0[3] * c1[2] + sg * p0[3] * c1[3];
                v1[0] = v1[0] * c2[0] + sg * p1[0] * c2[1]; v1[1] = v1[1] * c2[2] + sg * p1[1] * c2[3]; v1[2] = v1[2] * c3[0] + sg * p1[2] * c3[1]; v1[3] = v1[3] * c3[2] + sg * p1[3] * c3[3]; }
            v4u w; w.x = cvtpk(v0[0], v0[1]); w.y = cvtpk(v0[2], v0[3]); w.z = cvtpk(v1[0], v1[1]); w.w = cvtpk(v1[2], v1[3]);
            if (col0 >= C::O_KV && col0 < C::O_KV + C::AKVW) *(v4u*)(KR + (unsigned)(row * C::AKVW + (col0 - C::O_KV))) = w; else *(v4u*)(PX + (unsigned)(row * C::PXW + col0)) = w; })
        return true;
    } };
struct DEpiMerge { const bf16* PX; bf16* MIX;
    __device__ __forceinline__ bool operator()(f32x4 (&acc)[2][2][4][2], const pg8::Unit& u, int wr, int wc, int fr, int fq) const {
        const int i = u.tag;
#pragma unroll
        for (int ai = 0; ai < 2; ++ai) {
            v4u gt[4][2], pr[4][2];
#pragma unroll
            for (int m = 0; m < 4; ++m) { const int row = u.pm * 256 + ai * 128 + wr * 64 + m * 16 + fr;
#pragma unroll
                for (int bj = 0; bj < 2; ++bj) { const int col0 = u.pn * 256 + bj * 128 + wc * 32 + fq * 8;
                    gt[m][bj] = *(const v4u*)(PX + (unsigned)(row * C::PXW + C::O_GATE + i * C::D + col0));
                    if (i > 0) pr[m][bj] = *(const v4u*)(MIX + (unsigned)(row * C::D + col0)); } }
#pragma unroll
            for (int m = 0; m < 4; ++m) { const int row = u.pm * 256 + ai * 128 + wr * 64 + m * 16 + fr;
#pragma unroll
                for (int bj = 0; bj < 2; ++bj) { const int col0 = u.pn * 256 + bj * 128 + wc * 32 + fq * 8; f32x4 v0 = acc[ai][bj][m][0], v1 = acc[ai][bj][m][1]; const v4u g = gt[m][bj];
                    v0[0] *= bflo(g.x); v0[1] *= bfhi(g.x); v0[2] *= bflo(g.y); v0[3] *= bfhi(g.y); v1[0] *= bflo(g.z); v1[1] *= bfhi(g.z); v1[2] *= bflo(g.w); v1[3] *= bfhi(g.w);
                    if (i > 0) { const v4u q = pr[m][bj]; v0[0] += bflo(q.x); v0[1] += bfhi(q.x); v0[2] += bflo(q.y); v0[3] += bfhi(q.y); v1[0] += bflo(q.z); v1[1] += bfhi(q.z); v1[2] += bflo(q.w); v1[3] += bfhi(q.w); }
                    v4u w; w.x = cvtpk(v0[0], v0[1]); w.y = cvtpk(v0[2], v0[3]); w.z = cvtpk(v1[0], v1[1]); w.w = cvtpk(v1[2], v1[3]); *(v4u*)(MIX + (unsigned)(row * C::D + col0)) = w; } }
            asm volatile("" ::: "memory");
        }
        return true;
    } };
struct DEpiRes { float* X; const float* MODg; const float* xin; const float* cin;
    __device__ __forceinline__ bool operator()(f32x4 (&acc)[2][2][4][2], const pg8::Unit& u, int wr, int wc, int fr, int fq) const {
        const float* XS = xin ? (u.pm * 256 < C::MX ? xin : cin - (size_t)C::MX * C::D) : X;
        f32x4 g[2][2];
        { const float* gp = MODg + (unsigned)(mod_row<C>(u.pm * 256) * 6 * C::D + u.pn * 256 + wc * 32 + fq * 8);
#pragma unroll
          for (int bj = 0; bj < 2; ++bj)
#pragma unroll
            for (int n = 0; n < 2; ++n) g[bj][n] = *(const f32x4*)(gp + bj * 128 + n * 4); }
#pragma unroll
        for (int ai = 0; ai < 2; ++ai)
#pragma unroll
          for (int mp = 0; mp < 2; ++mp) {
            f32x4 x[2][2][2];
#pragma unroll
            for (int mm = 0; mm < 2; ++mm) { const int row = u.pm * 256 + ai * 128 + wr * 64 + (2 * mp + mm) * 16 + fr; const float* xp = XS + (unsigned)(row * C::D + u.pn * 256 + wc * 32 + fq * 8);
#pragma unroll
                for (int bj = 0; bj < 2; ++bj)
#pragma unroll
                    for (int n = 0; n < 2; ++n) x[mm][bj][n] = *(const f32x4*)(xp + bj * 128 + n * 4); }
#pragma unroll
            for (int mm = 0; mm < 2; ++mm) { const int row = u.pm * 256 + ai * 128 + wr * 64 + (2 * mp + mm) * 16 + fr; float* xp = X + (unsigned)(row * C::D + u.pn * 256 + wc * 32 + fq * 8);
#pragma unroll
                for (int bj = 0; bj < 2; ++bj)
#pragma unroll
                    for (int n = 0; n < 2; ++n) *(f32x4*)(xp + bj * 128 + n * 4) = x[mm][bj][n] + g[bj][n] * acc[ai][bj][2 * mp + mm][n]; }
            asm volatile("" ::: "memory");
          }
        return true;
    } };
struct DEpiResChain { float* X; const float* MODg; unsigned* flags; int nM; const float* xin; const float* cin;
    __device__ __forceinline__ bool operator()(f32x4 (&acc)[2][2][4][2], const pg8::Unit& u, int wr, int wc, int fr, int fq) const {
        if (u.tag == 0) return false;
        unsigned* flag = flags + 64 * (u.pn * nM + u.pm);
        if (u.tag == 3) {
            unsigned spins = 0; while (__hip_atomic_load(flag, __ATOMIC_RELAXED, __HIP_MEMORY_SCOPE_AGENT) == 0u && ++spins < (1u << 22)) __builtin_amdgcn_s_sleep(2);
            __builtin_amdgcn_fence(__ATOMIC_ACQUIRE, "agent"); asm volatile("s_waitcnt vmcnt(0)" ::: "memory");
        }
        DEpiRes inner{X, MODg, u.tag == 3 ? nullptr : xin, cin}; inner(acc, u, wr, wc, fr, fq);
        if (u.tag == 2) {
            asm volatile("s_waitcnt vmcnt(0)" ::: "memory"); __builtin_amdgcn_s_barrier(); asm volatile("" ::: "memory");
            if (threadIdx.x == 0) { __builtin_amdgcn_fence(__ATOMIC_RELEASE, "agent"); asm volatile("s_waitcnt vmcnt(0)" ::: "memory"); __hip_atomic_store(flag, 1u, __ATOMIC_RELAXED, __HIP_MEMORY_SCOPE_AGENT); }
        }
        return true;
    } };
struct DEpiMlp1 { bf16* U;
    __device__ __forceinline__ bool operator()(f32x4 (&acc)[2][2][4][2], const pg8::Unit& u, int wr, int wc, int fr, int fq) const {
        EPI_LOOP8({
            _Pragma("unroll") for (int e = 0; e < 4; ++e) { v0[e] = v0[e] > 0.f ? v0[e] * v0[e] : 0.f; v1[e] = v1[e] > 0.f ? v1[e] * v1[e] : 0.f; }
            v4u w; w.x = cvtpk(v0[0], v0[1]); w.y = cvtpk(v0[2], v0[3]); w.z = cvtpk(v1[0], v1[1]); w.w = cvtpk(v1[2], v1[3]); *(v4u*)(U + (unsigned)(row * C::HID + col0)) = w; })
        return true;
    } };
struct DEpiFno { bf16* FEATS; int L, row0;
    __device__ __forceinline__ bool operator()(f32x4 (&acc)[2][2][4][2], const pg8::Unit& u, int wr, int wc, int fr, int fq) const {
        EPI_LOOP({ const int b = col0 / C::BW, nn = col0 % C::BW; u32x2 w; w.x = cvtpk(v[0], v[1]); w.y = cvtpk(v[2], v[3]);
            *(u32x2*)(FEATS + (unsigned)((row0 + b * L + row) * C::D + nn)) = w; })
        return true;
    } };

constexpr int PS_NSTEP = C::CT + C::S, PS_STEPF = 6 * C::RH;
__device__ __forceinline__ size_t ps_off(int d, int b, int h, int s) { return ((((size_t)d * C::B + b) * C::RNH + h) * PS_NSTEP + s) * PS_STEPF; }
__device__ __forceinline__ int ps_step(int d, bool isc, int t) { return isc ? (d == 0 ? t : C::CT - 1 - t) : C::CT + (d == 0 ? t : C::S - 1 - t); }
constexpr int PREP_ROWS = 32;
__device__ __forceinline__ void prep_phase(const Ctx& c, int l, LAS unsigned char* lds, int tid, int vcu, int G) {
    LAS float* ft = (LAS float*)lds;
    const int ch = tid, h = tid >> 6, cl = tid & 63;
    constexpr int NCH = C::MA / PREP_ROWS;
    float* PS = c.PR();
    for (int unit = vcu; unit < 2 * NCH; unit += G) {
        const int d = unit / NCH, chunk = unit % NCH, row0 = chunk * PREP_ROWS;
        int b, t0, L, base; bool isc; row_info<C>(row0, b, t0, L, base, isc);
        const float* mu = c.mu() + ((size_t)l * 2 + d) * C::SHW;
        const int dt = d == 0 ? 1 : -1;
        { const int fi = tid & 127, lcol = C::O_LORA + d * C::DLW + fi; const float mu_l = mu[3 * C::BW + fi];
#pragma unroll
          for (int q = 0; q < PREP_ROWS / 4; ++q) { const int i = (tid >> 7) + 4 * q, t = t0 + i, tp = t - dt;
              const float fl = bf2f(c.PX()[(size_t)(base + t) * C::PXW + lcol]); const float pl = (tp >= 0 && tp < L) ? bf2f(c.PX()[(size_t)(base + tp) * C::PXW + lcol]) : 0.f;
              const float m = fl + mu_l * (pl - fl); ft[i * 128 + fi] = fi < C::DL ? ftanh(m) : m; } }
        __syncthreads();
        float wreg[C::DL];
#pragma unroll
        for (int j = 0; j < C::DL; ++j) wreg[j] = (c.w_up() + (((size_t)l * 2 + d) * C::DL + j) * C::BW)[(unsigned)ch];
        { const float w0 = c.w0()[((size_t)l * 2 + d) * C::BW + ch];
#pragma unroll 1
          for (int i = 0; i < PREP_ROWS; ++i) { float wr = w0;
#pragma unroll
              for (int j = 0; j < C::DL; j += 4) { const f32x4 x = *(const LAS f32x4*)(ft + i * 128 + j); wr += x[0] * wreg[j] + x[1] * wreg[j + 1] + x[2] * wreg[j + 2] + x[3] * wreg[j + 3]; }
              const float z = -wr; const float sp = (z > 0.f ? z : 0.f) + flog(1.0f + fexp(-fabsf(z)));
              PS[ps_off(d, b, h, ps_step(d, isc, t0 + i)) + C::RH + cl] = fexp(-fexp(-sp - 0.5f)); } }
#pragma unroll
        for (int j = 0; j < C::AL; ++j) wreg[j] = (c.a_up() + (((size_t)l * 2 + d) * C::AL + j) * C::BW)[(unsigned)ch];
        { const float mu_r = mu[ch], mu_k = mu[C::BW + ch], mu_v = mu[2 * C::BW + ch];
          const float a0 = c.a0()[((size_t)l * 2 + d) * C::BW + ch], kkw = c.k_k()[l * C::BW + ch], kaw = c.k_a()[l * C::BW + ch];
          const int tfirst = d == 0 ? t0 : t0 + PREP_ROWS - 1, tprev = tfirst - dt;
          float pr = 0.f, pk = 0.f, pv = 0.f;
          if (tprev >= 0 && tprev < L) { const bf16* p = c.PX() + (size_t)(base + tprev) * C::PXW; pr = bf2f(p[ch]); pk = bf2f(p[C::BW + ch]); pv = bf2f(p[2 * C::BW + ch]); }
          bf16 nr, nk, nv;
          { const bf16* p = c.PX() + (size_t)(base + tfirst) * C::PXW; nr = p[ch]; nk = p[C::BW + ch]; nv = p[2 * C::BW + ch]; }
#pragma unroll 1
          for (int i = 0; i < PREP_ROWS; ++i) {
              const int t = tfirst + dt * i;
              const float fr_ = bf2f(nr), fk_ = bf2f(nk), fv_ = bf2f(nv);
              if (i + 1 < PREP_ROWS) { const bf16* p = c.PX() + (size_t)(base + t + dt) * C::PXW; nr = p[ch]; nk = p[C::BW + ch]; nv = p[2 * C::BW + ch]; }
              const float r = fr_ + mu_r * (pr - fr_), k = fk_ + mu_k * (pk - fk_), v = fv_ + mu_v * (pv - fv_);
              pr = fr_; pk = fk_; pv = fv_;
              float ar = a0; const LAS float* fp = ft + (t - t0) * 128 + C::DL;
#pragma unroll
              for (int j = 0; j < C::AL; j += 4) { const f32x4 x = *(const LAS f32x4*)(fp + j); ar += x[0] * wreg[j] + x[1] * wreg[j + 1] + x[2] * wreg[j + 2] + x[3] * wreg[j + 3]; }
              const float a = fast_sigmoid(ar);
              const float kv = k * kkw; const float ss = wave_sum(kv * kv); const float nrm = sqrtf(ss);
              const float kk = kv * __builtin_amdgcn_rcpf(nrm > 1e-12f ? nrm : 1e-12f); const float krep = k * (1.0f + (a - 1.0f) * kaw);
              float* o = PS + ps_off(d, b, h, ps_step(d, isc, t)) + cl;
              o[0] = kk; o[2 * C::RH] = kk * a; o[3 * C::RH] = krep; o[4 * C::RH] = r; o[5 * C::RH] = v;
          } }
        __syncthreads();
    }
}
constexpr int RO_ROWS = 16;
struct RoIn { float y0, y1, r0, k0, v0, r1, k1, v1; bf16 gi; };
__device__ __forceinline__ RoIn ro_load(const Ctx& c, int row, int ch, int tid) {
    int b, t, L, base; bool isc; row_info<C>(row, b, t, L, base, isc);
    const int h = ch >> 6, cl = ch & 63; const float* PS = c.PR();
    const float* p0 = PS + ps_off(0, b, h, ps_step(0, isc, t)) + cl; const float* p1 = PS + ps_off(1, b, h, ps_step(1, isc, t)) + cl;
    RoIn x; x.y0 = c.Y()[(size_t)row * C::BW + ch]; x.y1 = c.Y()[((size_t)C::MA + row) * C::BW + ch];
    x.r0 = p0[4 * C::RH]; x.k0 = p0[3 * C::RH]; x.v0 = p0[5 * C::RH]; x.r1 = p1[4 * C::RH]; x.k1 = p1[3 * C::RH]; x.v1 = p1[5 * C::RH];
    x.gi = c.PX()[(size_t)row * C::PXW + C::O_G + (tid < C::GL ? tid : 0)]; return x;
}
__device__ __forceinline__ void readout_phase(const Ctx& c, int l, int nrows, LAS unsigned char* lds, int tid, int vcu, int G) {
    LAS float* lb = (LAS float*)lds;
    const int ch = tid, h = tid >> 6;
    float greg[C::GL];
#pragma unroll
    for (int j = 0; j < C::GL; ++j) greg[j] = (c.g_up() + ((size_t)l * C::GL + j) * C::BW)[(unsigned)ch];
    const float lg = c.lnx_g()[l * C::BW + ch], lbb = c.lnx_b()[l * C::BW + ch];
    const float rk0 = c.r_k()[(((size_t)l * 2 + 0) * C::RNH + h) * C::RH + (ch & 63)], rk1 = c.r_k()[(((size_t)l * 2 + 1) * C::RNH + h) * C::RH + (ch & 63)];
    int cur = 0;
    for (int unit = vcu; unit < nrows / RO_ROWS; unit += G) {
        RoIn nx = ro_load(c, unit * RO_ROWS, ch, tid);
        for (int i = 0; i < RO_ROWS; ++i) {
            const int row = unit * RO_ROWS + i; const RoIn x = nx;
            if (i + 1 < RO_ROWS) nx = ro_load(c, row + 1, ch, tid);
            if (tid < C::GL) lb[cur * 128 + tid] = fast_sigmoid(bf2f(x.gi));
            const float y = x.y0 + x.y1;
            const float mean = wave_sum(y) * (1.0f / C::RH); const float dv = y - mean; const float var = wave_sum(dv * dv) * (1.0f / C::RH);
            const float yn = dv * __builtin_amdgcn_rsqf(var + 64e-5f) * lg + lbb;
            const float s0 = wave_sum(x.r0 * x.k0 * rk0), s1 = wave_sum(x.r1 * x.k1 * rk1);
            const float bonus = s0 * x.v0 + s1 * x.v1;
            __syncthreads();
            float g = 0.f;
#pragma unroll
            for (int j = 0; j < C::GL; j += 4) { const f32x4 xx = *(const LAS f32x4*)(lb + cur * 128 + j); g += xx[0] * greg[j] + xx[1] * greg[j + 1] + xx[2] * greg[j + 2] + xx[3] * greg[j + 3]; if ((j & 12) == 12) asm volatile("" ::: "memory"); }
            c.FEATS()[(size_t)row * C::D + C::BW + ch] = f2bf((yn + bonus) * g);
            cur ^= 1;
        }
    }
    __syncthreads();
}
typedef float f32x16 __attribute__((ext_vector_type(16)));
typedef short s16x4 __attribute__((ext_vector_type(4)));
constexpr int AT_KSTR = 144, AT_VSTR = 648, AT_KOFF = 0, AT_VOFF = 320 * AT_KSTR;
__device__ __forceinline__ void attn_unit(const Ctx& c, int l, LAS unsigned char* lds, int tid, int b, int g, int qrow0, int tq0, bool ctxq) {
    const int lane = tid & 63, wave = __builtin_amdgcn_readfirstlane(tid >> 6), hl = wave >> 1, qh = wave & 1, ql = lane & 31, hi = lane >> 5;
    const int h = g * C::AREP + hl, qrow = qrow0 + 32 * qh + ql, tq = tq0 + 32 * qh + ql;
    bf16x8 qf[4];
#pragma unroll
    for (int s_ = 0; s_ < 4; ++s_) qf[s_] = *(const bf16x8*)(c.PX() + (size_t)qrow * C::PXW + C::O_Q + h * C::AH + 16 * s_ + 8 * hi);
    float m = c.sink()[l * C::ANH + h], lsum = hi == 0 ? 1.0f : 0.0f;
    f32x16 o0 = {}, o1 = {};
    const int npass = ctxq ? 1 : 2;
    for (int pass = 0; pass < npass; ++pass) {
        const int nk = pass == 0 ? C::CT : 2 * C::WIN + 64; const int jbase = tq0 - C::WIN;
        for (int it = tid; it < nk * 8; it += NTHR) {
            const int key = it >> 3, chn = it & 7; int row; bool valid = true;
            if (pass == 0) row = C::MX + b * C::CT + key; else { const int j = jbase + key; valid = j >= 0 && j < C::S; row = b * C::S + j; }
            v4u val = {0u, 0u, 0u, 0u};
            if (valid) val = *(const v4u*)(c.KR() + (size_t)row * C::AKVW + g * C::AH + chn * 8);
            *(LAS v4u*)(lds + AT_KOFF + key * AT_KSTR + chn * 16) = val;
        }
        for (int it = tid; it < nk * 8; it += NTHR) {
            const int dch = it / nk, key = it - dch * nk; int row; bool valid = true;
            if (pass == 0) row = C::MX + b * C::CT + key; else { const int j = jbase + key; valid = j >= 0 && j < C::S; row = b * C::S + j; }
            v4u val = {0u, 0u, 0u, 0u};
            if (valid) val = *(const v4u*)(c.PX() + (size_t)row * C::PXW + C::O_KV + C::AKVW + g * C::AH + dch * 8);
            LAS unsigned short* vt = (LAS unsigned short*)(lds + AT_VOFF) + (dch * 8) * (AT_VSTR / 2) + key;
            vt[0 * (AT_VSTR / 2)] = (unsigned short)(val.x & 0xffffu); vt[1 * (AT_VSTR / 2)] = (unsigned short)(val.x >> 16);
            vt[2 * (AT_VSTR / 2)] = (unsigned short)(val.y & 0xffffu); vt[3 * (AT_VSTR / 2)] = (unsigned short)(val.y >> 16);
            vt[4 * (AT_VSTR / 2)] = (unsigned short)(val.z & 0xffffu); vt[5 * (AT_VSTR / 2)] = (unsigned short)(val.z >> 16);
            vt[6 * (AT_VSTR / 2)] = (unsigned short)(val.w & 0xffffu); vt[7 * (AT_VSTR / 2)] = (unsigned short)(val.w >> 16);
        }
        __syncthreads();
        const int qa = tq0 + 32 * qh;
        for (int kt = 0; kt < nk / 32; ++kt) {
            const int jb = jbase + 32 * kt;
            if (pass == 1 && (jb + 31 < qa - C::WIN || jb > qa + 31 + C::WIN)) continue;
            f32x16 sacc = {};
#pragma unroll
            for (int s_ = 0; s_ < 4; ++s_) { const bf16x8 kf = *(const LAS bf16x8*)(lds + AT_KOFF + (32 * kt + ql) * AT_KSTR + (16 * s_ + 8 * hi) * 2);
                sacc = __builtin_amdgcn_mfma_f32_32x32x16_bf16(kf, qf[s_], sacc, 0, 0, 0); }
            float mx = -1e30f;
#pragma unroll
            for (int r = 0; r < 16; ++r) { float sv = sacc[r] * 0.125f;
                if (pass == 1) { const int j = jb + (r & 3) + 8 * (r >> 2) + 4 * hi; const int dj = j - tq; if (j < 0 || j >= C::S || dj > C::WIN || dj < -C::WIN) sv = -1e30f; }
                sacc[r] = sv; mx = fmaxf(mx, sv); }
            mx = fmaxf(mx, __shfl_xor(mx, 32));
            const float mn = fmaxf(m, mx), f = __builtin_amdgcn_exp2f((m - mn) * 1.4426950408889634f); m = mn;
            float ps = 0.f;
#pragma unroll
            for (int r = 0; r < 16; ++r) { const float p = __builtin_amdgcn_exp2f((sacc[r] - mn) * 1.4426950408889634f); sacc[r] = p; ps += p; }
            lsum = lsum * f + ps;
#pragma unroll
            for (int r = 0; r < 16; ++r) { o0[r] *= f; o1[r] *= f; }
            bf16x8 pb[2];
#pragma unroll
            for (int s_ = 0; s_ < 2; ++s_) { v4u w; w.x = cvtpk(sacc[8 * s_ + 0], sacc[8 * s_ + 1]); w.y = cvtpk(sacc[8 * s_ + 2], sacc[8 * s_ + 3]); w.z = cvtpk(sacc[8 * s_ + 4], sacc[8 * s_ + 5]); w.w = cvtpk(sacc[8 * s_ + 6], sacc[8 * s_ + 7]);
                pb[s_] = __builtin_bit_cast(bf16x8, w); }
#pragma unroll
            for (int s_ = 0; s_ < 2; ++s_) {
                const LAS unsigned char* vp = lds + AT_VOFF + ql * AT_VSTR + (32 * kt + 16 * s_ + 4 * hi) * 2;
                const s16x4 a0 = *(const LAS s16x4*)(vp), a1 = *(const LAS s16x4*)(vp + 16);
                const s16x4 b0 = *(const LAS s16x4*)(vp + 32 * AT_VSTR), b1 = *(const LAS s16x4*)(vp + 32 * AT_VSTR + 16);
                const bf16x8 va0 = {a0[0], a0[1], a0[2], a0[3], a1[0], a1[1], a1[2], a1[3]}, va1 = {b0[0], b0[1], b0[2], b0[3], b1[0], b1[1], b1[2], b1[3]};
                o0 = __builtin_amdgcn_mfma_f32_32x32x16_bf16(va0, pb[s_], o0, 0, 0, 0);
                o1 = __builtin_amdgcn_mfma_f32_32x32x16_bf16(va1, pb[s_], o1, 0, 0, 0);
            }
        }
        __syncthreads();
    }
    const float lt = lsum + __shfl_xor(lsum, 32), inv = 1.0f / lt;
    bf16* op = c.FEATS() + (size_t)qrow * C::D + 2 * C::BW + h * C::AH;
#pragma unroll
    for (int r4 = 0; r4 < 4; ++r4) {
        u32x2 w0, w1; w0.x = cvtpk(o0[4 * r4] * inv, o0[4 * r4 + 1] * inv); w0.y = cvtpk(o0[4 * r4 + 2] * inv, o0[4 * r4 + 3] * inv);
        w1.x = cvtpk(o1[4 * r4] * inv, o1[4 * r4 + 1] * inv); w1.y = cvtpk(o1[4 * r4 + 2] * inv, o1[4 * r4 + 3] * inv);
        *(u32x2*)(op + 8 * r4 + 4 * hi) = w0; *(u32x2*)(op + 32 + 8 * r4 + 4 * hi) = w1;
    }
}
__device__ __forceinline__ void attn_phase(const Ctx& c, int l, bool wc, LAS unsigned char* lds, int tid, int vcu, int G) {
    constexpr int NQB = C::S / 64, NXU = C::B * C::AKV * NQB, NCB = C::CT / 64, NCU = C::B * C::AKV * NCB;
    for (int u = vcu; u < NXU + (wc ? NCU : 0); u += G) {
        if (u < NXU) { const int qb = u % NQB, g = (u / NQB) % C::AKV, b = u / (NQB * C::AKV); attn_unit(c, l, lds, tid, b, g, b * C::S + qb * 64, qb * 64, false); }
        else { const int u2 = u - NXU; const int qb = u2 % NCB, g = (u2 / NCB) % C::AKV, b = u2 / (NCB * C::AKV); attn_unit(c, l, lds, tid, b, g, C::MX + b * C::CT + qb * 64, qb * 64, true); }
    }
}

constexpr int SC_STEPS = 32, SC_STEPB = PS_STEPF * 4, SC_BUFB = SC_STEPS * SC_STEPB;
template <int N> __device__ __forceinline__ float dpp_ror_add(float x) { const int y = __builtin_amdgcn_update_dpp(0, __builtin_bit_cast(int, x), 0x120 + N, 0xF, 0xF, false); return x + __builtin_bit_cast(float, y); }
__device__ __forceinline__ float row16_sum(float x) { x = dpp_ror_add<8>(x); x = dpp_ror_add<4>(x); x = dpp_ror_add<2>(x); x = dpp_ror_add<1>(x); return x; }
__device__ __forceinline__ int scan_row(int d, int b, int s) {
    if (s < C::CT) return C::MX + b * C::CT + (d == 0 ? s : C::CT - 1 - s);
    const int i = s - C::CT; return b * C::S + (d == 0 ? i : C::S - 1 - i);
}
struct ScanOps { f32x4 kk, w, kka, kr, r; float vv; };
__device__ __forceinline__ ScanOps scan_ld(const LAS unsigned char* p, int kg, int vr) {
    ScanOps o; o.kk = *(const LAS f32x4*)(p + kg * 16); o.w = *(const LAS f32x4*)(p + 256 + kg * 16); o.kka = *(const LAS f32x4*)(p + 512 + kg * 16);
    o.kr = *(const LAS f32x4*)(p + 768 + kg * 16); o.r = *(const LAS f32x4*)(p + 1024 + kg * 16); o.vv = *(const LAS float*)(p + 1280 + vr * 4); return o;
}
__device__ __forceinline__ void scan_phase(const Ctx& c, bool emit_ctx, LAS unsigned char* lds, int tid, int ucu, int UG) {
    const int lane = tid & 63, wave = __builtin_amdgcn_readfirstlane(tid >> 6);
    constexpr int NCHUNK = PS_NSTEP / SC_STEPS, NUNIT = 2 * C::B * C::RNH * 2, NPC = SC_BUFB / 1024 / NWAVES;
    for (int unit = ucu; unit < NUNIT; unit += UG) {
        const int hq = unit & 1, chain = unit >> 1, h = chain % C::RNH, b = (chain / C::RNH) % C::B, d = chain / (C::RNH * C::B);
        const float* src = c.PR() + ps_off(d, b, h, 0) + (size_t)wave * NPC * 256 + lane * 4;
#define SC_DMA(chunk, bufi) do { _Pragma("unroll") for (int q = 0; q < NPC; ++q) \
            __builtin_amdgcn_global_load_lds((const unsigned*)(src + (size_t)(chunk) * (SC_BUFB / 4) + q * 256), (LAS unsigned*)(lds + (bufi) * SC_BUFB + (wave * NPC + q) * 1024), 16, 0, 0); } while (0)
        const int kg = lane & 15, rloc = lane >> 4, vrow = 32 * hq + 4 * wave + rloc;
        float* yb = c.Y() + (size_t)d * C::MA * C::BW + h * C::RH + vrow;
        f32x4 S = {0.f, 0.f, 0.f, 0.f};
        SC_DMA(0, 0);
        asm volatile("s_waitcnt vmcnt(0)" ::: "memory"); __syncthreads();
        for (int k = 0; k < NCHUNK; ++k) {
            if (k + 1 < NCHUNK) SC_DMA(k + 1, (k + 1) & 1);
            const LAS unsigned char* bp = lds + (k & 1) * SC_BUFB;
            const bool emit = emit_ctx || k >= C::CT / SC_STEPS;
            const int row_k = scan_row(d, b, k * SC_STEPS), dt = d == 0 ? 1 : -1;
            ScanOps cur = scan_ld(bp, kg, vrow);
            float ykeep = 0.f;
#pragma unroll 2
            for (int s_ = 0; s_ < SC_STEPS; ++s_) {
                const ScanOps nx = scan_ld(bp + (s_ + 1 < SC_STEPS ? s_ + 1 : s_) * SC_STEPB, kg, vrow);
                float sa = -((S[0] * cur.kk[0] + S[1] * cur.kk[1]) + (S[2] * cur.kk[2] + S[3] * cur.kk[3]));
                sa = row16_sum(sa);
                S = S * cur.w + (sa * cur.kka + cur.vv * cur.kr);
                float y = (S[0] * cur.r[0] + S[1] * cur.r[1]) + (S[2] * cur.r[2] + S[3] * cur.r[3]);
                y = row16_sum(y);
                ykeep = (kg == (s_ & 15)) ? y : ykeep;
                if ((s_ & 15) == 15 && emit) yb[(size_t)(row_k + dt * ((s_ & ~15) + kg)) * C::BW] = ykeep;
                cur = nx;
            }
            asm volatile("s_waitcnt vmcnt(0)" ::: "memory"); __syncthreads();
        }
#undef SC_DMA
    }
}

template <int CTRL> __device__ __forceinline__ float dpp_add(float x) { const int y = __builtin_amdgcn_update_dpp(0, __builtin_bit_cast(int, x), CTRL, 0xF, 0xF, false); return x + __builtin_bit_cast(float, y); }
__device__ __forceinline__ float row8_sum(float x) { x = dpp_add<0xB1>(x); x = dpp_add<0x4E>(x); x = dpp_add<0x141>(x); return x; }
struct ScanOps8 { f32x4 kk0, kk1, w0, w1, ka0, ka1, kr0, kr1, r0, r1; float vv; };
__device__ __forceinline__ ScanOps8 scan_ld8(const LAS unsigned char* p, int kg, int vr) {
    ScanOps8 o; const LAS unsigned char* q = p + kg * 32;
    o.kk0 = *(const LAS f32x4*)(q); o.kk1 = *(const LAS f32x4*)(q + 16); o.w0 = *(const LAS f32x4*)(q + 256); o.w1 = *(const LAS f32x4*)(q + 272);
    o.ka0 = *(const LAS f32x4*)(q + 512); o.ka1 = *(const LAS f32x4*)(q + 528); o.kr0 = *(const LAS f32x4*)(q + 768); o.kr1 = *(const LAS f32x4*)(q + 784);
    o.r0 = *(const LAS f32x4*)(q + 1024); o.r1 = *(const LAS f32x4*)(q + 1040); o.vv = *(const LAS float*)(p + 1280 + vr * 4); return o;
}
__device__ __forceinline__ float hsum4(f32x4 a) { return (a[0] + a[1]) + (a[2] + a[3]); }
__device__ __forceinline__ void scan64_phase(const Ctx& c, bool emit_ctx, LAS unsigned char* lds, int tid, int ucu, int UG) {
    const int lane = tid & 63, wave = __builtin_amdgcn_readfirstlane(tid >> 6);
    constexpr int NCHUNK = PS_NSTEP / SC_STEPS, NUNIT = 2 * C::B * C::RNH, NPC = SC_BUFB / 1024 / NWAVES;
    for (int unit = ucu; unit < NUNIT; unit += UG) {
        const int chain = unit, h = chain % C::RNH, b = (chain / C::RNH) % C::B, d = chain / (C::RNH * C::B);
        const float* src = c.PR() + ps_off(d, b, h, 0) + (size_t)wave * NPC * 256 + lane * 4;
#define SC_DMA(chunk, bufi) do { _Pragma("unroll") for (int q = 0; q < NPC; ++q) \
            __builtin_amdgcn_global_load_lds((const unsigned*)(src + (size_t)(chunk) * (SC_BUFB / 4) + q * 256), (LAS unsigned*)(lds + (bufi) * SC_BUFB + (wave * NPC + q) * 1024), 16, 0, 0); } while (0)
        const int kg = lane & 7, rloc = lane >> 3, vrow = 8 * wave + rloc;
        float* yb = c.Y() + (size_t)d * C::MA * C::BW + h * C::RH + vrow;
        f32x4 S0 = {0.f, 0.f, 0.f, 0.f}, S1 = {0.f, 0.f, 0.f, 0.f};
        SC_DMA(0, 0);
        asm volatile("s_waitcnt vmcnt(0)" ::: "memory"); __syncthreads();
        for (int k = 0; k < NCHUNK; ++k) {
            if (k + 1 < NCHUNK) SC_DMA(k + 1, (k + 1) & 1);
            const LAS unsigned char* bp = lds + (k & 1) * SC_BUFB;
            const bool emit = emit_ctx || k >= C::CT / SC_STEPS;
            const int row_k = scan_row(d, b, k * SC_STEPS), dt = d == 0 ? 1 : -1;
            const LAS unsigned char* pp = bp + kg * 32; const LAS unsigned char* pv = bp + 1280 + vrow * 4;
#define SC_LD8(o) do { o.kk0 = *(const LAS f32x4*)(pp); o.kk1 = *(const LAS f32x4*)(pp + 16); o.w0 = *(const LAS f32x4*)(pp + 256); o.w1 = *(const LAS f32x4*)(pp + 272); \
                o.ka0 = *(const LAS f32x4*)(pp + 512); o.ka1 = *(const LAS f32x4*)(pp + 528); o.kr0 = *(const LAS f32x4*)(pp + 768); o.kr1 = *(const LAS f32x4*)(pp + 784); \
                o.r0 = *(const LAS f32x4*)(pp + 1024); o.r1 = *(const LAS f32x4*)(pp + 1040); o.vv = *(const LAS float*)(pv); pp += SC_STEPB; pv += SC_STEPB; } while (0)
#define SC_STEP(o, s_) do { \
                float sa = -hsum4(S0 * o.kk0 + S1 * o.kk1); \
                sa = row8_sum(sa); \
                S0 = S0 * o.w0 + (sa * o.ka0 + o.vv * o.kr0); S1 = S1 * o.w1 + (sa * o.ka1 + o.vv * o.kr1); \
                float y = hsum4(S0 * o.r0 + S1 * o.r1); \
                y = row8_sum(y); \
                ykeep = (kg == ((s_) & 7)) ? y : ykeep; \
                if (((s_) & 7) == 7 && emit) yb[(size_t)(row_k + dt * (((s_) & ~7) + kg)) * C::BW] = ykeep; } while (0)
            ScanOps8 ob3[3]; SC_LD8(ob3[0]); SC_LD8(ob3[1]);
            float ykeep = 0.f;
#pragma unroll
            for (int s_ = 0; s_ < SC_STEPS; ++s_) {
                if (s_ + 2 < SC_STEPS) SC_LD8(ob3[(s_ + 2) % 3]);
                SC_STEP(ob3[s_ % 3], s_);
            }
#undef SC_LD8
#undef SC_STEP
            asm volatile("s_waitcnt vmcnt(0)" ::: "memory"); __syncthreads();
        }
#undef SC_DMA
    }
}

constexpr int PM_FSTR = 272, PM_XSTR = 3 * C::BW * 2 + 16, PM_XOFF = 32 * PM_FSTR;
__device__ __forceinline__ float half32_sum(float x) { x = row16_sum(x); return x + __shfl_xor(x, 16); }
__device__ __forceinline__ void prep_mfma_phase(const Ctx& c, int l, LAS unsigned char* lds, int tid, int vcu, int G) {
    const int lane = tid & 63, h = __builtin_amdgcn_readfirstlane(tid >> 6), ql = lane & 31, hi = lane >> 5;
    constexpr int NCH = C::MA / 32;
    const int d = vcu & 1, dt = d == 0 ? 1 : -1;
    float* PS = c.PR();
    const float* mu = c.mu() + ((size_t)l * 2 + d) * C::SHW;
    bf16x8 wB[2][4], aB[2][4]; float w0[2], a0[2], kkw[2], kaw[2], mur[2], muk[2], muv[2];
#pragma unroll
    for (int ct = 0; ct < 2; ++ct) { const int ch = h * C::RH + 32 * ct + ql;
        w0[ct] = c.w0()[((size_t)l * 2 + d) * C::BW + ch]; a0[ct] = c.a0()[((size_t)l * 2 + d) * C::BW + ch]; kkw[ct] = c.k_k()[l * C::BW + ch]; kaw[ct] = c.k_a()[l * C::BW + ch];
        mur[ct] = mu[ch]; muk[ct] = mu[C::BW + ch]; muv[ct] = mu[2 * C::BW + ch];
#pragma unroll
        for (int s_ = 0; s_ < 4; ++s_) { const float* wp = c.w_up() + (((size_t)l * 2 + d) * C::DL + 16 * s_ + 8 * hi) * C::BW + ch; const float* ap = c.a_up() + (((size_t)l * 2 + d) * C::AL + 16 * s_ + 8 * hi) * C::BW + ch;
            v4u ww, aa; ww.x = cvtpk(wp[0], wp[C::BW]); ww.y = cvtpk(wp[2 * C::BW], wp[3 * C::BW]); ww.z = cvtpk(wp[4 * C::BW], wp[5 * C::BW]); ww.w = cvtpk(wp[6 * C::BW], wp[7 * C::BW]);
            aa.x = cvtpk(ap[0], ap[C::BW]); aa.y = cvtpk(ap[2 * C::BW], ap[3 * C::BW]); aa.z = cvtpk(ap[4 * C::BW], ap[5 * C::BW]); aa.w = cvtpk(ap[6 * C::BW], ap[7 * C::BW]);
            wB[ct][s_] = __builtin_bit_cast(bf16x8, ww); aB[ct][s_] = __builtin_bit_cast(bf16x8, aa); } }
    for (int chunk = vcu >> 1; chunk < NCH; chunk += G >> 1) {
        const int row0 = chunk * 32; int b, t0, L, base; bool isc; row_info<C>(row0, b, t0, L, base, isc);
        const int tlo = d == 0 ? t0 - 1 : t0;
        { const int fi = tid & 127, lcol = C::O_LORA + d * C::DLW + fi; const float mu_l = mu[3 * C::BW + fi];
#pragma unroll
          for (int q = 0; q < 8; ++q) { const int i = (tid >> 7) + 4 * q, t = t0 + i, tp = t - dt;
              const float fl = bf2f(c.PX()[(size_t)(base + t) * C::PXW + lcol]); const float pl = (tp >= 0 && tp < L) ? bf2f(c.PX()[(size_t)(base + tp) * C::PXW + lcol]) : 0.f;
              const float m = fl + mu_l * (pl - fl); *(LAS bf16*)(lds + i * PM_FSTR + fi * 2) = f2bf(fi < C::DL ? ftanh(m) : m); } }
        for (int it = tid; it < 33 * (3 * C::BW / 8); it += NTHR) { const int ti = it / (3 * C::BW / 8), c8 = it - ti * (3 * C::BW / 8), t = tlo + ti;
            v4u val = {0u, 0u, 0u, 0u}; if (t >= 0 && t < L) val = *(const v4u*)(c.PX() + (size_t)(base + t) * C::PXW + c8 * 8);
            *(LAS v4u*)(lds + PM_XOFF + ti * PM_XSTR + c8 * 16) = val; }
        __syncthreads();
        f32x16 accW[2] = {}, accA[2] = {};
#pragma unroll
        for (int s_ = 0; s_ < 4; ++s_) { const bf16x8 fw = *(const LAS bf16x8*)(lds + ql * PM_FSTR + (16 * s_ + 8 * hi) * 2), fa = *(const LAS bf16x8*)(lds + ql * PM_FSTR + (C::DL + 16 * s_ + 8 * hi) * 2);
#pragma unroll
            for (int ct = 0; ct < 2; ++ct) { accW[ct] = __builtin_amdgcn_mfma_f32_32x32x16_bf16(fw, wB[ct][s_], accW[ct], 0, 0, 0); accA[ct] = __builtin_amdgcn_mfma_f32_32x32x16_bf16(fa, aB[ct][s_], accA[ct], 0, 0, 0); } }
#pragma unroll
        for (int r = 0; r < 16; ++r) { const int i = (r & 3) + 8 * (r >> 2) + 4 * hi, t = t0 + i, ti = t - tlo, tip = ti - dt;
            float kx[2], rx[2], vx[2], ss = 0.f;
#pragma unroll
            for (int ct = 0; ct < 2; ++ct) { const int cl = 32 * ct + ql, ch = h * C::RH + cl;
                const LAS bf16* pc = (const LAS bf16*)(lds + PM_XOFF + ti * PM_XSTR) + ch; const LAS bf16* pp = (const LAS bf16*)(lds + PM_XOFF + tip * PM_XSTR) + ch;
                const float fr_ = bf2f(pc[0]), fk_ = bf2f(pc[C::BW]), fv_ = bf2f(pc[2 * C::BW]), pr = bf2f(pp[0]), pk = bf2f(pp[C::BW]), pv = bf2f(pp[2 * C::BW]);
                rx[ct] = fr_ + mur[ct] * (pr - fr_); kx[ct] = fk_ + muk[ct] * (pk - fk_); vx[ct] = fv_ + muv[ct] * (pv - fv_);
                const float kv = kx[ct] * kkw[ct]; ss += kv * kv; }
            ss = half32_sum(ss); const float rn = __builtin_amdgcn_rcpf(fmaxf(sqrtf(ss), 1e-12f));
            float* ob = PS + ps_off(d, b, h, ps_step(d, isc, t));
#pragma unroll
            for (int ct = 0; ct < 2; ++ct) { const int cl = 32 * ct + ql;
                const float wr = w0[ct] + accW[ct][r], ar = a0[ct] + accA[ct][r];
                const float z = -wr; const float sp = (z > 0.f ? z : 0.f) + flog(1.0f + fexp(-fabsf(z)));
                const float decay = fexp(-fexp(-sp - 0.5f)), a = fast_sigmoid(ar), kk = kx[ct] * kkw[ct] * rn;
                float* o = ob + cl; o[0] = kk; o[C::RH] = decay; o[2 * C::RH] = kk * a; o[3 * C::RH] = kx[ct] * (1.0f + (a - 1.0f) * kaw[ct]); o[4 * C::RH] = rx[ct]; o[5 * C::RH] = vx[ct]; } }
        __syncthreads();
    }
}
__device__ __forceinline__ void readout_mfma_phase(const Ctx& c, int l, int nrows, LAS unsigned char* lds, int tid, int vcu, int G) {
    const int lane = tid & 63, h = __builtin_amdgcn_readfirstlane(tid >> 6), ql = lane & 31, hi = lane >> 5;
    const float* PS = c.PR();
    bf16x8 gB[2][8]; float lg[2], lbb[2], rk0[2], rk1[2];
#pragma unroll
    for (int ct = 0; ct < 2; ++ct) { const int cl = 32 * ct + ql, ch = h * C::RH + cl;
        lg[ct] = c.lnx_g()[l * C::BW + ch]; lbb[ct] = c.lnx_b()[l * C::BW + ch];
        rk0[ct] = c.r_k()[(((size_t)l * 2 + 0) * C::RNH + h) * C::RH + cl]; rk1[ct] = c.r_k()[(((size_t)l * 2 + 1) * C::RNH + h) * C::RH + cl];
#pragma unroll
        for (int s_ = 0; s_ < 8; ++s_) { const float* gp = c.g_up() + ((size_t)l * C::GL + 16 * s_ + 8 * hi) * C::BW + ch;
            v4u ww; ww.x = cvtpk(gp[0], gp[C::BW]); ww.y = cvtpk(gp[2 * C::BW], gp[3 * C::BW]); ww.z = cvtpk(gp[4 * C::BW], gp[5 * C::BW]); ww.w = cvtpk(gp[6 * C::BW], gp[7 * C::BW]);
            gB[ct][s_] = __builtin_bit_cast(bf16x8, ww); } }
    for (int unit = vcu; unit < nrows / 32; unit += G) {
        const int row0 = unit * 32; int b, t0, L, base; bool isc; row_info<C>(row0, b, t0, L, base, isc);
        { const int fi = tid & 127;
#pragma unroll
          for (int q = 0; q < 8; ++q) { const int i = (tid >> 7) + 4 * q;
              *(LAS bf16*)(lds + i * PM_FSTR + fi * 2) = f2bf(fast_sigmoid(bf2f(c.PX()[(size_t)(row0 + i) * C::PXW + C::O_G + fi]))); } }
        __syncthreads();
        f32x16 accG[2] = {};
#pragma unroll
        for (int s_ = 0; s_ < 8; ++s_) { const bf16x8 fa = *(const LAS bf16x8*)(lds + ql * PM_FSTR + (16 * s_ + 8 * hi) * 2);
#pragma unroll
            for (int ct = 0; ct < 2; ++ct) accG[ct] = __builtin_amdgcn_mfma_f32_32x32x16_bf16(fa, gB[ct][s_], accG[ct], 0, 0, 0); }
#pragma unroll
        for (int rg = 0; rg < 4; ++rg) {
            float ya[4][2], yb[4][2], ra[4][2], ka[4][2], va[4][2], rb[4][2], kb[4][2], vb[4][2];
#pragma unroll
            for (int rr = 0; rr < 4; ++rr) { const int i = rr + 8 * rg + 4 * hi, row = row0 + i, t = t0 + i;
                const float* p0 = PS + ps_off(0, b, h, ps_step(0, isc, t)); const float* p1 = PS + ps_off(1, b, h, ps_step(1, isc, t));
                const float* y0p = c.Y() + (size_t)row * C::BW + h * C::RH; const float* y1p = c.Y() + ((size_t)C::MA + row) * C::BW + h * C::RH;
#pragma unroll
                for (int ct = 0; ct < 2; ++ct) { const int cl = 32 * ct + ql; ya[rr][ct] = y0p[cl]; yb[rr][ct] = y1p[cl];
                    ra[rr][ct] = p0[4 * C::RH + cl]; ka[rr][ct] = p0[3 * C::RH + cl]; va[rr][ct] = p0[5 * C::RH + cl];
                    rb[rr][ct] = p1[4 * C::RH + cl]; kb[rr][ct] = p1[3 * C::RH + cl]; vb[rr][ct] = p1[5 * C::RH + cl]; } }
#pragma unroll
            for (int rr = 0; rr < 4; ++rr) { const int r = 4 * rg + rr, i = rr + 8 * rg + 4 * hi, row = row0 + i;
                float y[2], sm = 0.f, s0 = 0.f, s1 = 0.f;
#pragma unroll
                for (int ct = 0; ct < 2; ++ct) { y[ct] = ya[rr][ct] + yb[rr][ct]; sm += y[ct]; s0 += ra[rr][ct] * ka[rr][ct] * rk0[ct]; s1 += rb[rr][ct] * kb[rr][ct] * rk1[ct]; }
                const float mean = half32_sum(sm) * (1.0f / C::RH);
                float sq = 0.f;
#pragma unroll
                for (int ct = 0; ct < 2; ++ct) { y[ct] -= mean; sq += y[ct] * y[ct]; }
                const float rs = __builtin_amdgcn_rsqf(half32_sum(sq) * (1.0f / C::RH) + 64e-5f);
                s0 = half32_sum(s0); s1 = half32_sum(s1);
#pragma unroll
                for (int ct = 0; ct < 2; ++ct) { const int cl = 32 * ct + ql;
                    const float yn = y[ct] * rs * lg[ct] + lbb[ct], bonus = s0 * va[rr][ct] + s1 * vb[rr][ct];
                    c.FEATS()[(size_t)row * C::D + C::BW + h * C::RH + cl] = f2bf((yn + bonus) * accG[ct][r]); } }
        }
        __syncthreads();
    }
}
__device__ __forceinline__ void el_tbd(bf16* T, long idx) {
    const int np = (int)(idx / C::BW), k = (int)(idx % C::BW), g = np / (2 * C::FGW), j = np % (2 * C::FGW), g2 = k / C::FGW, cc = k % C::FGW;
    float v = 0.f;
    if (g == g2) { const int jj = j % C::FGW; const float ang = 6.283185307179586f * (float)((jj * cc) % C::FGW) / (float)C::FGW; v = j < C::FGW ? cosf(ang) : -sinf(ang); }
    T[idx] = f2bf(v);
}
struct DEpiFnoA { bf16* YT; bf16* YTC;
    __device__ __forceinline__ bool operator()(f32x4 (&acc)[2][2][4][2], const pg8::Unit& u, int wr, int wc, int fr, int fq) const {
        EPI_LOOP({ int b, t, L, base; bool isc; row_info<C>(row, b, t, L, base, isc);
            const int g = col0 / (2 * C::FGW), j = col0 % (2 * C::FGW), im = j >= C::FGW ? 1 : 0, n = g * C::FGW + (j - im * C::FGW);
            bf16* dst = (isc ? YTC : YT) + ((size_t)b * C::BW + n) * 2 * L + im * L + t;
            dst[0] = f2bf(v[0]); dst[2 * L] = f2bf(v[1]); dst[4 * L] = f2bf(v[2]); dst[6 * L] = f2bf(v[3]); })
        return true;
    } };
__device__ __forceinline__ void el_ropetab(float* R, long idx) {
    constexpr int nf = C::AH / 4; const int t = (int)(idx / (C::AH / 2)), e = (int)(idx % (C::AH / 2)), half = e / nf, i = e % nf;
    const int pos = half == 0 ? t / C::GW : t % C::GW; const float inv = powf(10000.0f, -(float)i / (float)nf), ang = (float)pos * inv;
    R[2 * idx] = cosf(ang); R[2 * idx + 1] = sinf(ang);
}
__device__ __forceinline__ void el_rope_fast(const Ctx& c, long idx) {
    constexpr int PPR = (C::BW + C::AKVW) / 2, nf = C::AH / 4;
    const int row = (int)(idx / PPR), pp = (int)(idx % PPR); const bool isq = pp < C::BW / 2; const int p2 = isq ? pp : pp - C::BW / 2;
    const int hd = p2 / (C::AH / 2), e = p2 % (C::AH / 2), half = e / nf, i = e % nf, d1 = half * (C::AH / 2) + i, d2 = d1 + nf;
    const bf16* src = c.PX() + (size_t)row * C::PXW + (isq ? C::O_Q : C::O_KV) + hd * C::AH;
    bf16* dst = (isq ? c.QR() + (size_t)row * C::BW : c.KR() + (size_t)row * C::AKVW) + hd * C::AH;
    const float u1 = bf2f(src[d1]), u2 = bf2f(src[d2]);
    if (row >= C::MX) { dst[d1] = src[d1]; dst[d2] = src[d2]; return; }
    const int t = row % C::S; const float cs = c.ROPE()[((size_t)t * (C::AH / 2) + e) * 2], sn = c.ROPE()[((size_t)t * (C::AH / 2) + e) * 2 + 1];
    dst[d1] = f2bf(u1 * cs - u2 * sn); dst[d2] = f2bf(u2 * cs + u1 * sn);
}
constexpr int CV_T = 32;
__device__ __forceinline__ void conv_phase(const Ctx& c, int l, int nrows, LAS unsigned char* lds, int tid, int vcu, int G) {
    LAS float* cv = (LAS float*)lds;
    const int ch = tid, lane = tid & 63, wave = __builtin_amdgcn_readfirstlane(tid >> 6);
    constexpr int PAD = (C::CK - 1) / 2, NG = CV_T + C::CK - 1;
    float dw[C::CK];
#pragma unroll
    for (int j = 0; j < C::CK; ++j) dw[j] = c.conv_dw()[((size_t)l * C::CK + j) * C::BW + ch];
    const float bias = c.conv_dw_b()[l * C::BW + ch];
    for (int unit = vcu; unit < nrows / CV_T; unit += G) {
        const int row0 = unit * CV_T; int b, t0, L, base; bool isc; row_info<C>(row0, b, t0, L, base, isc);
        float gl[NG];
#pragma unroll
        for (int i = 0; i < NG; ++i) { const int tt = t0 + i - PAD; float v = 0.f;
            if (tt >= 0 && tt < L) { const bf16* p = c.PX() + (size_t)(base + tt) * C::PXW + C::O_CONV; v = bf2f(p[ch]) * fast_sigmoid(bf2f(p[C::BW + ch])); }
            gl[i] = v; }
#pragma unroll
        for (int i = 0; i < CV_T; ++i) { float s_ = bias;
#pragma unroll
            for (int j = 0; j < C::CK; ++j) s_ += gl[i + j] * dw[j];
            cv[i * C::BW + ch] = s_; }
        __syncthreads();
#pragma unroll
        for (int q = 0; q < CV_T / NWAVES; ++q) { const int i = wave * (CV_T / NWAVES) + q; float v[C::BW / 64]; float sm = 0.f;
#pragma unroll
            for (int e = 0; e < C::BW / 64; ++e) { v[e] = cv[i * C::BW + e * 64 + lane]; sm += v[e]; }
            const float mean = wave_sum(sm) * (1.0f / C::BW); float sq = 0.f;
#pragma unroll
            for (int e = 0; e < C::BW / 64; ++e) { v[e] -= mean; sq += v[e] * v[e]; }
            const float rs = 1.0f / sqrtf(wave_sum(sq) * (1.0f / C::BW) + 1e-5f);
#pragma unroll
            for (int e = 0; e < C::BW / 64; ++e) { const int k = e * 64 + lane; const float y = v[e] * rs * c.conv_ln_g()[l * C::BW + k] + c.conv_ln_b()[l * C::BW + k];
                c.FEATS()[(size_t)(row0 + i) * C::D + 3 * C::BW + k] = f2bf(y * fast_sigmoid(y)); } }
        __syncthreads();
    }
}
__device__ __forceinline__ void mod_partial_phase(const Ctx& c, LAS unsigned char* lds, int tid, int vcu, int G) {
    LAS float* sv = (LAS float*)lds;
    constexpr int NKC = C::D / 64, NCC = 6 * C::D / 2048, NU = C::DEPTH * NKC * NCC;
    static_assert(NKC == 32, "MODP holds 32 k chunks");
    for (int unit = vcu; unit < NU; unit += G) {
        const int cc = unit % NCC, kc = (unit / NCC) % NKC, l = unit / (NCC * NKC), k0 = kc * 64, col = cc * 2048 + tid * 4;
        if (tid < (C::B + 1) * 64) { const int r = tid / 64, k = tid % 64; const float x = r < C::B ? c.c()[r * C::D + k0 + k] : c.c_ctx()[k0 + k]; sv[tid] = x * sigmoidf_(x); }
        __syncthreads();
        f32x4 acc[C::B + 1];
#pragma unroll
        for (int r = 0; r <= C::B; ++r) acc[r] = (f32x4){0.f, 0.f, 0.f, 0.f};
        const float* wp = c.ada_w() + ((size_t)l * C::D + k0) * 6 * C::D + col;
#pragma unroll 8
        for (int k = 0; k < 64; ++k) { const f32x4 w = *(const f32x4*)(wp + (size_t)k * 6 * C::D);
#pragma unroll
            for (int r = 0; r <= C::B; ++r) acc[r] += sv[r * 64 + k] * w; }
#pragma unroll
        for (int r = 0; r <= C::B; ++r) *(f32x4*)(c.MODP() + (((size_t)kc * C::DEPTH + l) * (C::B + 1) + r) * 6 * C::D + col) = acc[r];
        __syncthreads();
    }
}
__device__ __forceinline__ void el_mod_reduce(const Ctx& c, long idx) {
    const int j = (int)(idx % (6 * C::D)); const int l = (int)(idx / ((long)(C::B + 1) * 6 * C::D));
    float s_ = c.ada_b()[l * 6 * C::D + j];
    for (int kc = 0; kc < 32; ++kc) s_ += c.MODP()[(size_t)kc * C::DEPTH * (C::B + 1) * 6 * C::D + idx];
    c.MOD()[idx] = s_;
}
__device__ __forceinline__ void hx_phase(const Ctx& c, int l, int which, int nrows, int lane, int gw, int NGW) {
    const float* gn = (which ? c.norm2_g() : c.norm1_g()) + l * C::D;
    for (int row = gw; row < nrows; row += NGW) {
        const float* xr = (l == 0 && which == 0) ? (row < C::MX ? c.x() + (size_t)row * C::D : c.ctx() + (size_t)(row - C::MX) * C::D) : c.X() + (size_t)row * C::D;
        const float* m = c.MOD() + ((size_t)l * (C::B + 1) + mod_row<C>(row)) * 6 * C::D;
        f32x4 v[C::D / 256]; float s_ = 0.f;
#pragma unroll
        for (int j = 0; j < C::D / 256; ++j) { v[j] = *(const f32x4*)(xr + (j * 64 + lane) * 4); s_ += (v[j][0] * v[j][0] + v[j][1] * v[j][1]) + (v[j][2] * v[j][2] + v[j][3] * v[j][3]); }
        const float rs = 1.0f / sqrtf(wave_sum(s_) * (1.0f / C::D) + 1e-6f);
#pragma unroll
        for (int j = 0; j < C::D / 256; ++j) { const int col = (j * 64 + lane) * 4; const f32x4 g = *(const f32x4*)(gn + col), sh = *(const f32x4*)(m + (which ? 3 : 0) * C::D + col), sc = *(const f32x4*)(m + (which ? 4 : 1) * C::D + col);
            const f32x4 y = v[j] * rs * g * (1.0f + sc) + sh; u32x2 w; w.x = cvtpk(y[0], y[1]); w.y = cvtpk(y[2], y[3]); *(u32x2*)(c.HX() + (size_t)row * C::D + col) = w; }
    }
}

__device__ __forceinline__ void convert_weights(const Ctx& c, int kind, int l, LAS float* scr, int lane, int wv, int nwv, int tid, long gt, long gts) {
    if (kind == 0) {
        constexpr int I_IN = (C::D / 64) * (C::IN_W / 64), I_B = (C::BW / 64) * (C::D / 64), I_O = (C::D / 64) * (C::D / 64);
        for (int it = wv; it < I_IN + 4 * I_B + I_O; it += nwv) {
            int r = it;
            if (r < I_IN) { transpose_item64(c.w_in() + (size_t)l * C::D * C::IN_W, C::D, C::IN_W, c.WinT(), scr, r, lane); continue; } r -= I_IN;
            if (r < 4 * I_B) { const int br = r / I_B; transpose_item64(c.w_branch() + ((size_t)l * 4 + br) * C::BW * C::D, C::BW, C::D, c.WbT() + (size_t)br * C::D * C::BW, scr, r % I_B, lane); continue; } r -= 4 * I_B;
            transpose_item64(c.w_out() + (size_t)l * C::D * C::D, C::D, C::D, c.WoT(), scr, r, lane);
        }
        for (long i = gt; i < (long)(C::PXW - C::IN_W) * C::D; i += gts) c.WinT()[(long)C::IN_W * C::D + i] = (bf16)0;
    } else {
        constexpr int I_1 = (C::D / 64) * (C::HID / 64), I_2 = (C::HID / 64) * (C::D / 64);
        for (int it = wv; it < I_1 + I_2; it += nwv) {
            if (it < I_1) transpose_item64(c.w_mlp1() + (size_t)l * C::D * C::HID, C::D, C::HID, c.W1T(), scr, it, lane);
            else transpose_item64(c.w_mlp2() + (size_t)l * C::HID * C::D, C::HID, C::D, c.W2T(), scr, it - I_1, lane);
        }
    }
    (void)tid;
}

struct Args { const float* in[30]; float* out; unsigned char* ws; };

__global__ void __launch_bounds__(NTHR, 2) mega_fwd(Args args) {
    extern __shared__ __attribute__((aligned(16))) unsigned char lds_raw[];
    LAS unsigned char* lds = (LAS unsigned char*)lds_raw;
    const int tid = threadIdx.x, lane = tid & 63, wave = __builtin_amdgcn_readfirstlane(tid >> 6);
    const int G = gridDim.x; const int bx = blockIdx.x; const int vcu = (G % 8 == 0) ? (bx % 8) * (G / 8) + bx / 8 : bx;
    const long gstride = (long)G * NTHR;
    const int gw = vcu * NWAVES + wave, NGW = G * NWAVES;
    typedef const CONSTAS Args* KArgs;
    KArgs ka = (KArgs)__builtin_amdgcn_kernarg_segment_ptr();
    unsigned char* ws = ka->ws;
#define PHASE_CTX() int tidp = threadIdx.x; asm volatile("" : "+v"(tidp)); const int lanep = tidp & 63; const long gtidp = (long)vcu * NTHR + tidp; Ctx c; { KArgs k_ = ka; asm volatile("" : "+s"(k_)); c.in = k_->in; c.out = k_->out; c.ws = k_->ws; }
    for (int u = tid; u < (LDS_BYTES - LDSCTL_OFF) / 4; u += NTHR) ((LAS unsigned*)(lds + LDSCTL_OFF))[u] = 0u;
    __syncthreads();
    volatile LAS unsigned* MISC = (volatile LAS unsigned*)(lds + MISC_OFF);
    XcdBarrier bar = xcd_barrier_post((unsigned*)(ws + WSMap::CTL) + CW_BAR, MISC + 8, (unsigned)G, true);
    const bool split = (G == 256); const bool is_scan = split && (vcu & 31) < 8;
    const int sidx = (vcu >> 5) * 8 + (vcu & 31), nidx = split ? (vcu >> 5) * 24 + (vcu & 31) - 8 : vcu, NG2 = split ? 192 : G;
    XcdBarrier bar2 = xcd_barrier_post((unsigned*)(ws + WSMap::CTL) + CW_BAR + XCD_BAR_WORDS, MISC + 10, 192u, split && !is_scan);
#define GRID_BAR() do { xcd_barrier(bar); if ((PROBE) == 99) xcd_barrier(bar); } while (0)
#define SUB_BAR() do { if (split) xcd_barrier(bar2); else xcd_barrier(bar); } while (0)
#define GSL(n, body) do { for (long i_ = gtidp; i_ < (long)(n); i_ += gstride) { body; } } while (0)
    LAS float* scr = (LAS float*)(lds + wave * 16384);

    RP(0) { PHASE_CTX();
#if EN_EL_DFT_TABLE
    GSL((long)C::S * 2 * C::S, el_dft_table<C>(c.TX(), C::S, i_));
#endif
#if EN_EL_DFT_TABLE
    GSL((long)C::CT * 2 * C::CT, el_dft_table<C>(c.TC(), C::CT, i_));
#endif
    GSL((long)2 * C::BW * C::BW, el_tbd(c.TBD(), i_));
    GSL((long)C::S * (C::AH / 2), el_ropetab(c.ROPE(), i_));
    mod_partial_phase(c, lds, tidp, vcu, G);
        }
    GRID_BAR();

    for (int l = 0; l < C::DEPTH; ++l) {
        const bool wc = l < C::DEPTH - 1; const int nrows = wc ? C::MA : C::MX; const int nMr = nrows / 256;
        if (l == 0) {
        RP(1) { PHASE_CTX();
            convert_weights(c, 0, 0, scr, lanep, gw, NGW, tidp, gtidp, gstride);
            GSL((long)C::DEPTH * (C::B + 1) * 6 * C::D, el_mod_reduce(c, i_));
        }
        GRID_BAR();
        }
        RP(2) { PHASE_CTX(); hx_phase(c, l, 0, C::MA, lanep, gw, NGW); }
        GRID_BAR();
        constexpr int NSTT = C::O_KV / 256;
        static_assert(C::O_KV % 256 == 0, "state columns end on a tile boundary");
        const int nsc = G >= 256 ? 64 : 0;
        RP(3) { PHASE_CTX();
            pg8::Gemm g{c.HX(), c.WinT(), C::D, C::D, C::D};
            pg8::RectSched S; S.G = G; S.c = vcu; S.nbr = 1; S.lda2 = (long)C::D * 2; S.ldb2 = (long)C::D * 2; S.abr = 0; S.bbr = 0;
            S.pm0_0 = 0; S.nM_0 = C::MX / 256; S.pn0_0 = 0; S.nN_0 = NSTT; S.blocked = true; S.bm = 4; S.bn = NSTT;
            S.pm0_1 = C::MX / 256; S.nM_1 = C::MC / 256; S.pn0_1 = 0; S.nN_1 = wc ? NSTT : C::CSC / 256;
            DEpiPX E{c.PX(), c.ROPE(), c.KR()};
            pg8::gemm_phase(lds, g, S, E, tidp);
        }
        GRID_BAR();
        { PHASE_CTX();
        RP(40) prep_mfma_phase(c, l, lds, tidp, vcu, G);
        }
        GRID_BAR();
        if (!split || is_scan) { PHASE_CTX();
            RP(50) scan64_phase(c, wc, lds, tidp, split ? sidx : vcu, split ? 64 : G);
        }
        if (!split) GRID_BAR();
        if (!split || !is_scan) {
            RP(31) { PHASE_CTX();
                pg8::Gemm g{c.HX(), c.WinT(), C::D, C::D, C::D};
                pg8::RectSched S; S.G = NG2; S.c = nidx; S.nbr = 1; S.lda2 = (long)C::D * 2; S.ldb2 = (long)C::D * 2; S.abr = 0; S.bbr = 0;
                S.pm0_0 = 0; S.nM_0 = C::MX / 256; S.pn0_0 = NSTT; S.nN_0 = C::PXW / 256 - NSTT; if (split && (C::PXW / 256 - NSTT) % 6 == 0) { S.blocked = true; S.bm = 4; S.bn = 6; }
                S.pm0_1 = C::MX / 256; S.nM_1 = C::MC / 256; S.pn0_1 = NSTT; S.nN_1 = wc ? C::PXW / 256 - NSTT : 0;
                DEpiPX E{c.PX(), c.ROPE(), c.KR()};
                pg8::gemm_phase(lds, g, S, E, tidp);
            }
            SUB_BAR();
            { PHASE_CTX();
            RP(42) conv_phase(c, l, nrows, lds, tidp, nidx, NG2);
            RP(43) {
                pg8::Gemm g{c.PX() + C::O_FNO, c.TBD(), C::PXW, C::BW, C::BW};
                pg8::RectSched S; S.G = NG2; S.c = nidx; S.nbr = 1; S.lda2 = (long)C::PXW * 2; S.ldb2 = (long)C::BW * 2; S.abr = 0; S.bbr = 0;
                S.pm0_0 = 0; int nMp = nMr; asm volatile("" : "+s"(nMp)); S.nM_0 = nMp; S.pn0_0 = 0; S.nN_0 = 2 * C::BW / 256; S.pm0_1 = 0; S.nM_1 = 0; S.pn0_1 = 0; S.nN_1 = 0;
                DEpiFnoA E{c.YT(), c.YTC()};
                pg8::gemm_phase(lds, g, S, E, tidp);
            }
            }
            SUB_BAR();
            RP(52) { PHASE_CTX();
                pg8::Gemm g{c.TX(), c.YT(), 2 * C::S, 2 * C::S, 2 * C::S};
                pg8::RectSched S; S.G = NG2; S.c = nidx; S.nbr = 1; S.lda2 = (long)2 * C::S * 2; S.ldb2 = (long)2 * C::S * 2; S.abr = 0; S.bbr = 0;
                S.pm0_0 = 0; S.nM_0 = C::S / 256; S.pn0_0 = 0; S.nN_0 = C::B * C::BW / 256; S.pm0_1 = 0; S.nM_1 = 0; S.pn0_1 = 0; S.nN_1 = 0;
                DEpiFno E{c.FEATS(), C::S, 0};
                pg8::gemm_phase(lds, g, S, E, tidp);
            }
            if (wc) { PHASE_CTX();
                pg8::Gemm g{c.TC(), c.YTC(), 2 * C::CT, 2 * C::CT, 2 * C::CT};
                pg8::RectSched S; S.G = NG2; S.c = (nidx + NG2 - 64) % NG2; S.nbr = 1; S.lda2 = (long)2 * C::CT * 2; S.ldb2 = (long)2 * C::CT * 2; S.abr = 0; S.bbr = 0;
                S.pm0_0 = 0; S.nM_0 = C::CT / 256; S.pn0_0 = 0; S.nN_0 = C::B * C::BW / 256; S.pm0_1 = 0; S.nM_1 = 0; S.pn0_1 = 0; S.nN_1 = 0;
                DEpiFno E{c.FEATS(), C::CT, C::MX};
                pg8::gemm_phase(lds, g, S, E, tidp);
            }
            { PHASE_CTX();
            const int na = NG2 > 144 ? NG2 - 72 : NG2;
            if (na == NG2 || nidx >= 72) RP(51) attn_phase(c, l, wc, lds, tidp, na == NG2 ? nidx : nidx - 72, na);
            }
        }
        GRID_BAR();
        RP(6) { PHASE_CTX(); readout_mfma_phase(c, l, nrows, lds, tidp, vcu, G); }
        GRID_BAR();
        RP(7) { PHASE_CTX();
            pg8::Gemm g{c.FEATS(), c.WbT(), C::D, C::BW, C::BW};
            pg8::RectSched S; S.G = G; S.c = vcu; S.nbr = 4; S.lda2 = (long)C::D * 2; S.ldb2 = (long)C::BW * 2; S.abr = (long)C::BW * 2; S.bbr = (long)C::D * C::BW * 2;
            S.pm0_0 = 0; int nMp = nMr; asm volatile("" : "+s"(nMp)); S.nM_0 = nMp; S.pn0_0 = 0; S.nN_0 = C::D / 256; S.pm0_1 = 0; S.nM_1 = 0; S.pn0_1 = 0; S.nN_1 = 0; S.blocked = true;
            DEpiMerge E{c.PX(), c.MIX()};
            pg8::gemm_phase(lds, g, S, E, tidp);
            { const int ntl = nMr * (C::D / 256), n2 = ntl > G ? ntl - G : 0;
              if (vcu >= n2) convert_weights(c, 1, l, scr, lanep, (vcu - n2) * NWAVES + wave, (G - n2) * NWAVES, tidp, 0, 1); }
        }
        GRID_BAR();
        { PHASE_CTX();
            const int ntl = nMr * (C::D / 256);
            if (ntl > G && (ntl * 8) % G == 0 && ntl * 8 / G >= 8) {
                pg8::Gemm g{c.MIX(), c.WoT(), C::D, C::D, C::D / 8};
                pg8::ChainSched S; S.G = G; S.c = vcu; int nMp = nMr; asm volatile("" : "+s"(nMp)); S.nM = nMp; S.ntl = ntl; S.nsl = 8; S.per = ntl * 8 / G; S.lda2 = (long)C::D * 2; S.ldb2 = (long)C::D * 2; S.ksl = (long)(C::D / 8) * 2;
                DEpiResChain E{c.X(), c.MOD() + (size_t)l * (C::B + 1) * 6 * C::D + 2 * C::D, (unsigned*)(c.ws + WSMap::CTL) + CW_FLAGS + (2 * l) * FLAG_BANK, nMp, l == 0 ? c.x() : nullptr, c.ctx()};
                pg8::gemm_phase(lds, g, S, E, tidp);
            } else {
            pg8::Gemm g{c.MIX(), c.WoT(), C::D, C::D, C::D};
            pg8::RectSched S; S.G = G; S.c = vcu; S.nbr = 1; S.lda2 = (long)C::D * 2; S.ldb2 = (long)C::D * 2; S.abr = 0; S.bbr = 0;
            S.pm0_0 = 0; int nMp = nMr; asm volatile("" : "+s"(nMp)); S.nM_0 = nMp; S.pn0_0 = 0; S.nN_0 = C::D / 256; S.pm0_1 = 0; S.nM_1 = 0; S.pn0_1 = 0; S.nN_1 = 0; S.blocked = true;
            DEpiRes E{c.X(), c.MOD() + (size_t)l * (C::B + 1) * 6 * C::D + 2 * C::D, l == 0 ? c.x() : nullptr, c.ctx()};
            pg8::gemm_phase(lds, g, S, E, tidp);
            }
        }
        GRID_BAR();
        RP(9) { PHASE_CTX();
            hx_phase(c, l, 1, nrows, lanep, gw, NGW);
        }
        GRID_BAR();
        RP(10) { PHASE_CTX();
            pg8::Gemm g{c.HX(), c.W1T(), C::D, C::D, C::D};
            pg8::RectSched S; S.G = G; S.c = vcu; S.nbr = 1; S.lda2 = (long)C::D * 2; S.ldb2 = (long)C::D * 2; S.abr = 0; S.bbr = 0;
            S.pm0_0 = 0; int nMp = nMr; asm volatile("" : "+s"(nMp)); S.nM_0 = nMp; S.pn0_0 = 0; S.nN_0 = C::HID / 256; S.pm0_1 = 0; S.nM_1 = 0; S.pn0_1 = 0; S.nN_1 = 0; S.blocked = true;
            DEpiMlp1 E{c.U()};
#if EN_GEMM && (GEMM_MASK & 32)
            pg8::gemm_phase(lds, g, S, E, tidp);
#endif
        }
        GRID_BAR();
        { PHASE_CTX();
            const int ntl = nMr * (C::D / 256), n2 = ntl > G ? ntl - G : 0;
            if (ntl > G && (ntl * 8) % G == 0 && ntl * 8 / G >= 8) {
                pg8::Gemm g{c.U(), c.W2T(), C::HID, C::HID, C::HID / 8};
                pg8::ChainSched S; S.G = G; S.c = vcu; int nMp = nMr; asm volatile("" : "+s"(nMp)); S.nM = nMp; S.ntl = ntl; S.nsl = 8; S.per = ntl * 8 / G; S.lda2 = (long)C::HID * 2; S.ldb2 = (long)C::HID * 2; S.ksl = (long)(C::HID / 8) * 2;
                DEpiResChain E{c.X(), c.MOD() + (size_t)l * (C::B + 1) * 6 * C::D + 5 * C::D, (unsigned*)(c.ws + WSMap::CTL) + CW_FLAGS + (2 * l + 1) * FLAG_BANK, nMp, nullptr, nullptr};
                pg8::gemm_phase(lds, g, S, E, tidp);
                if (l + 1 < C::DEPTH) convert_weights(c, 0, l + 1, scr, lanep, gw, NGW, tidp, gtidp, gstride);
            } else {
            pg8::Gemm g{c.U(), c.W2T(), C::HID, C::HID, C::HID};
            pg8::RectSched S; S.G = G; S.c = vcu; S.nbr = 1; S.lda2 = (long)C::HID * 2; S.ldb2 = (long)C::HID * 2; S.abr = 0; S.bbr = 0;
            S.pm0_0 = 0; int nMp = nMr; asm volatile("" : "+s"(nMp)); S.nM_0 = nMp; S.pn0_0 = 0; S.nN_0 = C::D / 256; S.pm0_1 = 0; S.nM_1 = 0; S.pn0_1 = 0; S.nN_1 = 0; S.blocked = true;
            DEpiRes E{c.X(), c.MOD() + (size_t)l * (C::B + 1) * 6 * C::D + 5 * C::D, nullptr, nullptr};
            pg8::gemm_phase(lds, g, S, E, tidp);
            if (l + 1 < C::DEPTH) { if (vcu >= n2) convert_weights(c, 0, l + 1, scr, lanep, (vcu - n2) * NWAVES + wave, (G - n2) * NWAVES, tidp, (long)(vcu - n2) * NTHR + tidp, (long)(G - n2) * NTHR); }
            }
        }
        GRID_BAR();
    }
    PHASE_CTX();
    for (int row = gw; row < C::MX; row += NGW) {
        const float* xr = c.X() + (size_t)row * C::D; float s = 0.f;
        for (int j = lanep; j < C::D; j += 64) s += xr[j] * xr[j];
        s = wave_sum(s); const float rs = 1.0f / sqrtf(s / (float)C::D + 1e-6f);
        for (int j = lanep; j < C::D; j += 64) c.out[(size_t)row * C::D + j] = xr[j] * rs * c.final_g()[j];
    }
}

extern "C" void kernel_launch(void* const* d_in, const int* in_sizes, int n_in, void* d_out, int out_size, void* d_ws, size_t ws_size, hipStream_t stream) {
    static int grid = 0;
    if (grid == 0) {
        if (n_in != 30 || out_size != C::MX * C::D || ws_size < WSMap::END) { fprintf(stderr, "kernel_launch: bad shapes: n_in %d out %d ws %zu (need %zu)\n", n_in, out_size, ws_size, (size_t)WSMap::END); grid = -1; return; }
        int dev = 0, cus = 0, per_cu = 0;
        if (hipGetDevice(&dev) != hipSuccess || hipDeviceGetAttribute(&cus, hipDeviceAttributeMultiprocessorCount, dev) != hipSuccess) { grid = -1; return; }
        if (hipFuncSetAttribute((const void*)mega_fwd, hipFuncAttributeMaxDynamicSharedMemorySize, LDS_BYTES) != hipSuccess) { fprintf(stderr, "kernel_launch: hipFuncSetAttribute failed\n"); grid = -1; return; }
        if (hipOccupancyMaxActiveBlocksPerMultiprocessor(&per_cu, (const void*)mega_fwd, NTHR, LDS_BYTES) != hipSuccess || per_cu < 1) { fprintf(stderr, "kernel_launch: occupancy query says %d\n", per_cu); grid = -1; return; }
        (void)hipGetLastError();
        grid = cus;
    }
    if (grid < 0) return;
    if (hipMemsetAsync((char*)d_ws + WSMap::CTL, 0, WSMap::CTL_BYTES, stream) != hipSuccess) return;
    Args a{};
    for (int i = 0; i < 30; ++i) a.in[i] = (const float*)d_in[i];
    a.out = (float*)d_out; a.ws = (unsigned char*)d_ws;
    hipLaunchKernelGGL(mega_fwd, dim3(grid), dim3(NTHR), LDS_BYTES, stream, a);
}
```

```cpp
#include <hip/hip_runtime.h>
#include <cstdio>
#include <cstdint>
#define HD __host__ __device__ __forceinline__
#define CONSTAS __attribute__((address_space(4)))
typedef unsigned short bf16;
HD float bf2f(bf16 h) { unsigned u = ((unsigned)h) << 16; float f; __builtin_memcpy(&f, &u, 4); return f; }
HD bf16 f2bf(float f) { unsigned u; __builtin_memcpy(&u, &f, 4); return (bf16)((u + 0x7fffu + ((u >> 16) & 1u)) >> 16); }
HD float sigmoidf_(float x) { return 1.0f / (1.0f + expf(-x)); }

template <int D_, int B_, int S_, int DEPTH_, int GW_, int CT_, int FG_, int RH_, int DL_, int AL_, int GL_, int AH_, int AKV_, int WIN_, int CK_>
struct CfgT {
    static constexpr int D = D_, B = B_, S = S_, DEPTH = DEPTH_, GW = GW_, CT = CT_;
    static constexpr int BW = D / 4, FG = FG_, FGW = BW / FG, RH = RH_, RNH = BW / RH, DL = DL_, AL = AL_, GL = GL_, DLW = DL + AL, SHW = 3 * BW + DLW;
    static constexpr int AH = AH_, ANH = BW / AH, AKV = AKV_, AREP = ANH / AKV, AKVW = AKV * AH, WIN = WIN_, CK = CK_, HID = 4 * D;
    static constexpr int O_LORA = 3 * BW, O_KV = O_LORA + 2 * DLW, CSC = O_KV + 2 * AKVW, O_G = CSC, O_Q = O_G + GL, O_FNO = O_Q + BW, O_CONV = O_FNO + BW,
                         O_GATE = O_CONV + 2 * BW, IN_W = O_GATE + 4 * D;
    static constexpr int PXW = (IN_W + 255) / 256 * 256;
    static constexpr int MX = B * S, MC = B * CT, MA = MX + MC;
};
typedef CfgT<2048, 4, 2048, 2, 64, 256, 4, 64, 64, 64, 128, 64, 2, 128, 31> CfgFull;
typedef CfgT<256, 2, 64, 2, 8, 16, 4, 16, 8, 8, 16, 16, 2, 8, 7> CfgSmall;

template <class C> struct WSMapT {
    static constexpr size_t al(size_t x) { return (x + 4095) / 4096 * 4096; }
};
constexpr size_t ws_al(size_t x) { return (x + 4095) / 4096 * 4096; }
template <class C> struct WSM {
    static constexpr size_t CTL = 0, CTL_BYTES = 1u << 20;
    static constexpr size_t MOD = CTL + CTL_BYTES;
    static constexpr size_t RSTD = MOD + ws_al((size_t)C::DEPTH * (C::B + 1) * 6 * C::D * 4);
    static constexpr size_t X = RSTD + ws_al((size_t)C::MA * 4);
    static constexpr size_t HX = X + ws_al((size_t)C::MA * C::D * 4);
    static constexpr size_t WREG = HX + ws_al((size_t)C::MA * C::D * 2);
    static constexpr size_t W2T = WREG, WoT = W2T + ws_al((size_t)C::D * C::HID * 2), WbT = WoT + ws_al((size_t)C::D * C::D * 2), U2 = WbT + ws_al((size_t)4 * C::D * C::BW * 2);
    static constexpr size_t WinT = U2, W1T = U2;
    static constexpr size_t WREG_END1 = WinT + ws_al((size_t)C::PXW * C::D * 2), WREG_END2 = W1T + ws_al((size_t)C::HID * C::D * 2);
    static constexpr size_t PX = WREG_END1 > WREG_END2 ? WREG_END1 : WREG_END2;
    static constexpr size_t PREP = PX + ws_al((size_t)C::MA * C::PXW * 2);
    static constexpr size_t PREP1 = ws_al((size_t)2 * C::MA * C::BW * 4);
    static constexpr size_t QR = PREP + 7 * PREP1;
    static constexpr size_t KR = QR + ws_al((size_t)C::MA * C::BW * 2);
    static constexpr size_t YT = KR + ws_al((size_t)C::MA * C::AKVW * 2);
    static constexpr size_t YTC = YT + ws_al((size_t)C::B * C::BW * 2 * C::S * 2);
    static constexpr size_t TX = YTC + ws_al((size_t)C::B * C::BW * 2 * C::CT * 2);
    static constexpr size_t TC = TX + ws_al((size_t)C::S * 2 * C::S * 2);
    static constexpr size_t FEATS = TC + ws_al((size_t)C::CT * 2 * C::CT * 2);
    static constexpr size_t TBD = FEATS + ws_al((size_t)C::MA * C::D * 2);
    static constexpr size_t ROPE = TBD + ws_al((size_t)2 * C::BW * C::BW * 2);
    static constexpr size_t MODP = ROPE + ws_al((size_t)C::S * (C::AH / 2) * 8);
    static constexpr size_t BS = MODP + ws_al((size_t)32 * C::DEPTH * (C::B + 1) * 6 * C::D * 4);
    static constexpr size_t END = BS + ws_al((size_t)2 * C::MA * C::RNH * 4);
    static_assert((size_t)C::MA * C::HID * 2 <= (size_t)C::MA * C::PXW * 2, "U overlays PX");
    static_assert((size_t)C::MA * C::D * 4 <= 7 * PREP1, "MSUM overlays PREP");
    static_assert((size_t)C::MA * C::BW * 4 <= (size_t)C::MA * C::D * 2, "CVB overlays HX");
};
template <class C> struct CtxT {
    const float* const CONSTAS* in; float* out; unsigned char* ws;
    typedef WSM<C> W;
    HD const float* x() const { return in[0]; }
    HD const float* c() const { return in[1]; }
    HD const float* ctx() const { return in[2]; }
    HD const float* c_ctx() const { return in[3]; }
    HD const float* ada_w() const { return in[4]; }
    HD const float* ada_b() const { return in[5]; }
    HD const float* norm1_g() const { return in[6]; }
    HD const float* norm2_g() const { return in[7]; }
    HD const float* w_in() const { return in[8]; }
    HD const float* mu() const { return in[9]; }
    HD const float* w0() const { return in[10]; }
    HD const float* w_up() const { return in[11]; }
    HD const float* a0() const { return in[12]; }
    HD const float* a_up() const { return in[13]; }
    HD const float* k_k() const { return in[14]; }
    HD const float* k_a() const { return in[15]; }
    HD const float* r_k() const { return in[16]; }
    HD const float* g_up() const { return in[17]; }
    HD const float* lnx_g() const { return in[18]; }
    HD const float* lnx_b() const { return in[19]; }
    HD const float* sink() const { return in[20]; }
    HD const float* conv_dw() const { return in[21]; }
    HD const float* conv_dw_b() const { return in[22]; }
    HD const float* conv_ln_g() const { return in[23]; }
    HD const float* conv_ln_b() const { return in[24]; }
    HD const float* w_branch() const { return in[25]; }
    HD const float* w_out() const { return in[26]; }
    HD const float* w_mlp1() const { return in[27]; }
    HD const float* w_mlp2() const { return in[28]; }
    HD const float* final_g() const { return in[29]; }
    HD float* MOD() const { return (float*)(ws + W::MOD); }
    HD float* X() const { return (float*)(ws + W::X); }
    HD float* RSTD() const { return (float*)(ws + W::RSTD); }
    HD bf16* HX() const { return (bf16*)(ws + W::HX); }
    HD bf16* MIX() const { return (bf16*)(ws + W::HX); }
    HD float* CVB() const { return (float*)(ws + W::HX); }
    HD bf16* WinT() const { return (bf16*)(ws + W::WinT); }
    HD bf16* WbT() const { return (bf16*)(ws + W::WbT); }
    HD bf16* WoT() const { return (bf16*)(ws + W::WoT); }
    HD bf16* W1T() const { return (bf16*)(ws + W::W1T); }
    HD bf16* W2T() const { return (bf16*)(ws + W::W2T); }
    HD bf16* PX() const { return (bf16*)(ws + W::PX); }
    HD bf16* U() const { return (bf16*)(ws + W::PX); }
    HD float* PR() const { return (float*)(ws + W::PREP); }
    HD float* PW() const { return (float*)(ws + W::PREP + W::PREP1); }
    HD float* PK() const { return (float*)(ws + W::PREP + 2 * W::PREP1); }
    HD float* PV() const { return (float*)(ws + W::PREP + 3 * W::PREP1); }
    HD float* PKK() const { return (float*)(ws + W::PREP + 4 * W::PREP1); }
    HD float* PA() const { return (float*)(ws + W::PREP + 5 * W::PREP1); }
    HD float* Y() const { return (float*)(ws + W::PREP + 6 * W::PREP1); }
    HD float* MSUM() const { return (float*)(ws + W::PREP); }
    HD bf16* QR() const { return (bf16*)(ws + W::QR); }
    HD bf16* KR() const { return (bf16*)(ws + W::KR); }
    HD bf16* YT() const { return (bf16*)(ws + W::YT); }
    HD bf16* YTC() const { return (bf16*)(ws + W::YTC); }
    HD bf16* TX() const { return (bf16*)(ws + W::TX); }
    HD bf16* TC() const { return (bf16*)(ws + W::TC); }
    HD bf16* FEATS() const { return (bf16*)(ws + W::FEATS); }
    HD bf16* TBD() const { return (bf16*)(ws + W::TBD); }
    HD float* ROPE() const { return (float*)(ws + W::ROPE); }
    HD float* MODP() const { return (float*)(ws + W::MODP); }
    HD float* BS() const { return (float*)(ws + W::BS); }
};

template <class C> HD void row_info(int row, int& b, int& t, int& L, int& base, bool& isctx) {
    if (row < C::MX) { b = row / C::S; t = row % C::S; L = C::S; base = b * C::S; isctx = false; }
    else { const int r = row - C::MX; b = r / C::CT; t = r % C::CT; L = C::CT; base = C::MX + b * C::CT; isctx = true; }
}
template <class C> HD int mod_row(int row) { return row < C::MX ? row / C::S : C::B; }

template <class C> HD void el_xcopy(const CtxT<C>& c, long idx) {
    c.X()[idx] = idx < (long)C::MX * C::D ? c.x()[idx] : c.ctx()[idx - (long)C::MX * C::D];
}
template <class C> HD void el_dft_table(bf16* T, int L, long idx) {
    const int t = (int)(idx / (2 * L)), k = (int)(idx % (2 * L));
    const int kk = k < L ? k : k - L; const int m = (int)(((long)t * kk) % L);
    const float ang = 6.283185307179586f * (float)m / (float)L;
    const float v = (k < L ? cosf(ang) : sinf(ang)) / sqrtf((float)L * (float)C::FGW);
    T[idx] = f2bf(v);
}
template <class C> HD void el_mod(const CtxT<C>& c, long idx) {
    const int l = (int)(idx / (6 * C::D)), j = (int)(idx % (6 * C::D));
    float acc[C::B + 1];
#pragma unroll
    for (int r = 0; r <= C::B; ++r) acc[r] = 0.f;
    for (int k = 0; k < C::D; ++k) {
        const float w = c.ada_w()[((long)l * C::D + k) * 6 * C::D + j];
#pragma unroll
        for (int r = 0; r <= C::B; ++r) { const float cv = r < C::B ? c.c()[r * C::D + k] : c.c_ctx()[k]; acc[r] += cv * sigmoidf_(cv) * w; }
    }
    const float bb = c.ada_b()[l * 6 * C::D + j];
#pragma unroll
    for (int r = 0; r <= C::B; ++r) c.MOD()[((long)l * (C::B + 1) + r) * 6 * C::D + j] = acc[r] + bb;
}
HD void el_wt(bf16* dst, const float* src, int K, int Nsrc, long idx) { const int n = (int)(idx / K), k = (int)(idx % K); dst[idx] = n < Nsrc ? f2bf(src[(long)k * Nsrc + n]) : (bf16)0; }

template <class C> HD void el_rstd(const CtxT<C>& c, int row) {
    float s = 0.f; const float* xr = c.X() + (long)row * C::D;
    for (int j = 0; j < C::D; ++j) s += xr[j] * xr[j];
    c.RSTD()[row] = 1.0f / sqrtf(s / (float)C::D + 1e-6f);
}
template <class C> HD void el_hx(const CtxT<C>& c, int l, int which, long idx) {
    const int row = (int)(idx / C::D), j = (int)(idx % C::D);
    const float* m = c.MOD() + ((long)l * (C::B + 1) + mod_row<C>(row)) * 6 * C::D;
    const float g = (which ? c.norm2_g() : c.norm1_g())[l * C::D + j];
    const float sh = m[(which ? 3 : 0) * C::D + j], sc = m[(which ? 4 : 1) * C::D + j];
    c.HX()[idx] = f2bf(c.X()[idx] * c.RSTD()[row] * g * (1.0f + sc) + sh);
}
template <class Epi> HD void el_gemm4(const bf16* A, int lda, const bf16* Bt, int ldb, int N, int K, const Epi& epi, long idx) {
    const int row = (int)(idx / (N / 4)), col0 = (int)(idx % (N / 4)) * 4;
    float v[4] = {0.f, 0.f, 0.f, 0.f};
    const bf16* a = A + (long)row * lda;
    for (int k = 0; k < K; ++k) { const float av = bf2f(a[k]);
#pragma unroll
        for (int q = 0; q < 4; ++q) v[q] += av * bf2f(Bt[(long)(col0 + q) * ldb + k]); }
    epi(row, col0, v);
}
template <class C> struct EpiPX { const CtxT<C>* c;
    HD void operator()(int row, int col0, const float* v) const {
#pragma unroll
        for (int q = 0; q < 4; ++q) { const int col = col0 + q; float y = v[q]; if (col >= C::O_GATE) y = sigmoidf_(y); c->PX()[(long)row * C::PXW + col] = f2bf(y); } } };
template <class C> struct EpiMerge { const CtxT<C>* c; int i;
    HD void operator()(int row, int col0, const float* v) const {
#pragma unroll
        for (int q = 0; q < 4; ++q) { const int col = col0 + q; float y = v[q] * bf2f(c->PX()[(long)row * C::PXW + C::O_GATE + i * C::D + col]);
            const long o = (long)row * C::D + col; if (i > 0) y += c->MSUM()[o]; if (i < 3) c->MSUM()[o] = y; else c->MIX()[o] = f2bf(y); } } };
template <class C> struct EpiRes { const CtxT<C>* c; int l, gidx;
    HD void operator()(int row, int col0, const float* v) const {
        const float* m = c->MOD() + ((long)l * (C::B + 1) + mod_row<C>(row)) * 6 * C::D + gidx * C::D;
#pragma unroll
        for (int q = 0; q < 4; ++q) { const long o = (long)row * C::D + col0 + q; c->X()[o] += m[col0 + q] * v[q]; } } };
template <class C> struct EpiMlp1 { const CtxT<C>* c;
    HD void operator()(int row, int col0, const float* v) const {
#pragma unroll
        for (int q = 0; q < 4; ++q) { const float r = v[q] > 0.f ? v[q] : 0.f; c->U()[(long)row * C::HID + col0 + q] = f2bf(r * r); } } };
template <class C> struct EpiFno { const CtxT<C>* c; int L, row0;
    HD void operator()(int t, int col0, const float* v) const {
#pragma unroll
        for (int q = 0; q < 4; ++q) { const int col = col0 + q, b = col / C::BW, n = col % C::BW; c->FEATS()[(long)(row0 + b * L + t) * C::D + n] = f2bf(v[q]); } } };

template <class C> HD float shiftfeat(const CtxT<C>& c, int l, int d, int row, int prow, int i) {
    const int col = i < 3 * C::BW ? i : C::O_LORA + d * C::DLW + (i - 3 * C::BW);
    const float f = bf2f(c.PX()[(long)row * C::PXW + col]);
    const float fp = prow >= 0 ? bf2f(c.PX()[(long)prow * C::PXW + col]) : 0.f;
    return f + c.mu()[((long)l * 2 + d) * C::SHW + i] * (fp - f);
}
template <class C> HD void el_prep(const CtxT<C>& c, int l, long idx) {
    const int ch = (int)(idx % C::BW); const long t2 = idx / C::BW; const int row = (int)(t2 % C::MA), d = (int)(t2 / C::MA);
    int b, t, L, base; bool isc; row_info<C>(row, b, t, L, base, isc);
    const int prow = d == 0 ? (t > 0 ? row - 1 : -1) : (t < L - 1 ? row + 1 : -1);
    const float r = shiftfeat<C>(c, l, d, row, prow, ch), k = shiftfeat<C>(c, l, d, row, prow, C::BW + ch), v = shiftfeat<C>(c, l, d, row, prow, 2 * C::BW + ch);
    float wr = c.w0()[((long)l * 2 + d) * C::BW + ch], ar = c.a0()[((long)l * 2 + d) * C::BW + ch];
    for (int j = 0; j < C::DL; ++j) wr += tanhf(shiftfeat<C>(c, l, d, row, prow, 3 * C::BW + j)) * c.w_up()[(((long)l * 2 + d) * C::DL + j) * C::BW + ch];
    for (int j = 0; j < C::AL; ++j) ar += shiftfeat<C>(c, l, d, row, prow, 3 * C::BW + C::DL + j) * c.a_up()[(((long)l * 2 + d) * C::AL + j) * C::BW + ch];
    const float z = -wr; const float sp = (z > 0.f ? z : 0.f) + log1pf(expf(-fabsf(z)));
    const float decay = expf(-expf(-sp - 0.5f));
    const float a = sigmoidf_(ar);
    const int h = ch / C::RH; float ss = 0.f;
    for (int c2 = h * C::RH; c2 < (h + 1) * C::RH; ++c2) { const float kv = shiftfeat<C>(c, l, d, row, prow, C::BW + c2) * c.k_k()[l * C::BW + c2]; ss += kv * kv; }
    const float nrm = sqrtf(ss); const float kk = k * c.k_k()[l * C::BW + ch] / (nrm > 1e-12f ? nrm : 1e-12f);
    const float krep = k * (1.0f + (a - 1.0f) * c.k_a()[l * C::BW + ch]);
    const long o = ((long)d * C::MA + row) * C::BW + ch;
    c.PR()[o] = r; c.PW()[o] = decay; c.PK()[o] = krep; c.PV()[o] = v; c.PKK()[o] = kk; c.PA()[o] = a;
}
template <class C> HD void el_scan(const CtxT<C>& c, bool emit_ctx, long idx) {
    const int vr = (int)(idx % C::RH); long t2 = idx / C::RH; const int h = (int)(t2 % C::RNH); t2 /= C::RNH; const int b = (int)(t2 % C::B), d = (int)(t2 / C::B);
    float S[C::RH];
#pragma unroll
    for (int k = 0; k < C::RH; ++k) S[k] = 0.f;
    for (int ph = 0; ph < 2; ++ph) {
        const int L = ph == 0 ? C::CT : C::S, base = ph == 0 ? C::MX + b * C::CT : b * C::S; const bool emit = ph == 1 || emit_ctx;
        for (int i = 0; i < L; ++i) {
            const int t = d == 0 ? i : L - 1 - i; const long off = ((long)d * C::MA + base + t) * C::BW + h * C::RH;
            float sa = 0.f;
#pragma unroll
            for (int k = 0; k < C::RH; ++k) sa -= S[k] * c.PKK()[off + k];
            const float vv = c.PV()[off + vr]; float y = 0.f;
#pragma unroll
            for (int k = 0; k < C::RH; ++k) { S[k] = S[k] * c.PW()[off + k] + sa * (c.PKK()[off + k] * c.PA()[off + k]) + vv * c.PK()[off + k]; y += S[k] * c.PR()[off + k]; }
            if (emit) c.Y()[off + vr] = y;
        }
    }
}
template <class C> HD void el_readout(const CtxT<C>& c, int l, long idx) {
    const int row = (int)(idx / C::BW), ch = (int)(idx % C::BW), h = ch / C::RH;
    const long o0 = (long)row * C::BW + h * C::RH, o1 = ((long)C::MA + row) * C::BW + h * C::RH;
    float mean = 0.f;
    for (int k = 0; k < C::RH; ++k) mean += c.Y()[o0 + k] + c.Y()[o1 + k];
    mean /= (float)C::RH; float var = 0.f;
    for (int k = 0; k < C::RH; ++k) { const float dv = c.Y()[o0 + k] + c.Y()[o1 + k] - mean; var += dv * dv; }
    var /= (float)C::RH;
    const float y = c.Y()[o0 + ch - h * C::RH] + c.Y()[o1 + ch - h * C::RH];
    const float yn = (y - mean) / sqrtf(var + 64e-5f) * c.lnx_g()[l * C::BW + ch] + c.lnx_b()[l * C::BW + ch];
    float bonus = 0.f;
    for (int d = 0; d < 2; ++d) { const long od = d == 0 ? o0 : o1; float s = 0.f;
        for (int k = 0; k < C::RH; ++k) s += c.PR()[od + k] * c.PK()[od + k] * c.r_k()[(((long)l * 2 + d) * C::RNH + h) * C::RH + k];
        bonus += s * c.PV()[od + ch - h * C::RH]; }
    float g = 0.f;
    for (int j = 0; j < C::GL; ++j) g += sigmoidf_(bf2f(c.PX()[(long)row * C::PXW + C::O_G + j])) * c.g_up()[((long)l * C::GL + j) * C::BW + ch];
    c.FEATS()[(long)row * C::D + 1 * C::BW + ch] = f2bf((yn + bonus) * g);
}
template <class C> HD float rope_el(const bf16* src, int dd, int t, bool rot) {
    const float u = bf2f(src[dd]); if (!rot) return u;
    constexpr int hs = C::AH / 2, nf = hs / 2;
    const int half = dd / hs, dp = dd % hs, i = dp % nf; const bool first = dp < nf;
    const int pos = half == 0 ? t / C::GW : t % C::GW;
    const float inv = powf(10000.0f, -(float)i / (float)nf), ang = (float)pos * inv, cs = cosf(ang), sn = sinf(ang);
    const float p = bf2f(src[first ? dd + nf : dd - nf]);
    return first ? u * cs - p * sn : u * cs + p * sn;
}
template <class C> HD void el_rope(const CtxT<C>& c, long idx) {
    const int row = (int)(idx / (C::BW + C::AKVW)), j = (int)(idx % (C::BW + C::AKVW));
    int b, t, L, base; bool isc; row_info<C>(row, b, t, L, base, isc);
    if (j < C::BW) { const int h = j / C::AH, dd = j % C::AH; c.QR()[(long)row * C::BW + j] = f2bf(rope_el<C>(c.PX() + (long)row * C::PXW + C::O_Q + h * C::AH, dd, t, !isc)); }
    else { const int j2 = j - C::BW, g = j2 / C::AH, dd = j2 % C::AH; c.KR()[(long)row * C::AKVW + j2] = f2bf(rope_el<C>(c.PX() + (long)row * C::PXW + C::O_KV + g * C::AH, dd, t, !isc)); }
}
template <class C> HD void el_attn(const CtxT<C>& c, int l, long idx) {
    const int row = (int)(idx / C::ANH), h = (int)(idx % C::ANH), g = h / C::AREP;
    int b, t, L, base; bool isc; row_info<C>(row, b, t, L, base, isc);
    float q[C::AH], acc[C::AH];
#pragma unroll
    for (int dd = 0; dd < C::AH; ++dd) { q[dd] = bf2f(c.QR()[(long)row * C::BW + h * C::AH + dd]); acc[dd] = 0.f; }
    const float scale = 1.0f / sqrtf((float)C::AH);
    float m = c.sink()[l * C::ANH + h], den = 1.0f;
    const int nloc = isc ? 0 : 2 * C::WIN + 1;
    for (int jj = 0; jj < nloc + C::CT; ++jj) {
        int krow;
        if (jj < nloc) { const int j = t - C::WIN + jj; if (j < 0 || j >= L) continue; krow = base + j; }
        else krow = C::MX + b * C::CT + (jj - nloc);
        const bf16* kp = c.KR() + (long)krow * C::AKVW + g * C::AH; float s = 0.f;
#pragma unroll
        for (int dd = 0; dd < C::AH; ++dd) s += q[dd] * bf2f(kp[dd]);
        s *= scale;
        const float mn = s > m ? s : m, f = expf(m - mn), p = expf(s - mn);
        const bf16* vp = c.PX() + (long)krow * C::PXW + C::O_KV + C::AKVW + g * C::AH;
        den = den * f + p;
#pragma unroll
        for (int dd = 0; dd < C::AH; ++dd) acc[dd] = acc[dd] * f + p * bf2f(vp[dd]);
        m = mn;
    }
#pragma unroll
    for (int dd = 0; dd < C::AH; ++dd) c.FEATS()[(long)row * C::D + 2 * C::BW + h * C::AH + dd] = f2bf(acc[dd] / den);
}
template <class C> HD void el_fnoA(const CtxT<C>& c, long idx) {
    const int row = (int)(idx / C::BW), n = (int)(idx % C::BW), g = n / C::FGW, cf = n % C::FGW;
    int b, t, L, base; bool isc; row_info<C>(row, b, t, L, base, isc);
    float ar = 0.f, ai = 0.f;
    for (int cp = 0; cp < C::FGW; ++cp) { const float u = bf2f(c.PX()[(long)row * C::PXW + C::O_FNO + g * C::FGW + cp]);
        const float ang = 6.283185307179586f * (float)((cf * cp) % C::FGW) / (float)C::FGW; ar += u * cosf(ang); ai -= u * sinf(ang); }
    bf16* yt = (isc ? c.YTC() : c.YT()) + ((long)b * C::BW + n) * 2 * L;
    yt[t] = f2bf(ar); yt[L + t] = f2bf(ai);
}
template <class C> HD void el_conv(const CtxT<C>& c, int l, long idx) {
    const int row = (int)(idx / C::BW), ch = (int)(idx % C::BW);
    int b, t, L, base; bool isc; row_info<C>(row, b, t, L, base, isc);
    float s = c.conv_dw_b()[l * C::BW + ch];
    for (int j = 0; j < C::CK; ++j) { const int tt = t + j - (C::CK - 1) / 2; if (tt < 0 || tt >= L) continue;
        const bf16* p = c.PX() + (long)(base + tt) * C::PXW + C::O_CONV;
        s += bf2f(p[ch]) * sigmoidf_(bf2f(p[C::BW + ch])) * c.conv_dw()[((long)l * C::CK + j) * C::BW + ch]; }
    c.CVB()[idx] = s;
}
template <class C> HD void el_convln(const CtxT<C>& c, int l, int row) {
    const float* v = c.CVB() + (long)row * C::BW; float mean = 0.f;
    for (int k = 0; k < C::BW; ++k) mean += v[k];
    mean /= (float)C::BW; float var = 0.f;
    for (int k = 0; k < C::BW; ++k) { const float dv = v[k] - mean; var += dv * dv; }
    var /= (float)C::BW; const float rs = 1.0f / sqrtf(var + 1e-5f);
    for (int k = 0; k < C::BW; ++k) { const float y = (v[k] - mean) * rs * c.conv_ln_g()[l * C::BW + k] + c.conv_ln_b()[l * C::BW + k]; c.FEATS()[(long)row * C::D + 3 * C::BW + k] = f2bf(y * sigmoidf_(y)); }
}
template <class C> HD void el_final(const CtxT<C>& c, int row) {
    float s = 0.f; const float* xr = c.X() + (long)row * C::D;
    for (int j = 0; j < C::D; ++j) s += xr[j] * xr[j];
    const float rs = 1.0f / sqrtf(s / (float)C::D + 1e-6f);
    for (int j = 0; j < C::D; ++j) c.out[(long)row * C::D + j] = xr[j] * rs * c.final_g()[j];
}
typedef CfgFull C;
#ifndef PROBE
#define PROBE -1
#endif
#define RP(k) for (int rp_ = 0; rp_ < ((PROBE) == (k) ? 2 : 1); ++rp_)
#ifndef GEMM_MASK
#define GEMM_MASK 0xFF
#endif
#ifndef EN_ALL
#define EN_ALL 1
#endif
#ifndef EN_GEMM
#define EN_GEMM EN_ALL
#endif
#ifndef EN_EL_XCOPY
#define EN_EL_XCOPY EN_ALL
#endif
#ifndef EN_EL_DFT_TABLE
#define EN_EL_DFT_TABLE EN_ALL
#endif
#ifndef EN_EL_MOD
#define EN_EL_MOD EN_ALL
#endif
#ifndef EN_MISC
#define EN_MISC EN_ALL
#endif
#ifndef EN_EL_HX
#define EN_EL_HX EN_ALL
#endif
#ifndef EN_EL_PREP
#define EN_EL_PREP EN_ALL
#endif
#ifndef EN_EL_ROPE
#define EN_EL_ROPE EN_ALL
#endif
#ifndef EN_EL_FNOA
#define EN_EL_FNOA EN_ALL
#endif
#ifndef EN_EL_CONV
#define EN_EL_CONV EN_ALL
#endif
#ifndef EN_EL_SCAN
#define EN_EL_SCAN EN_ALL
#endif
#ifndef EN_EL_ATTN
#define EN_EL_ATTN EN_ALL
#endif
#ifndef EN_EL_CONVLN
#define EN_EL_CONVLN EN_ALL
#endif
#ifndef EN_EL_READOUT
#define EN_EL_READOUT EN_ALL
#endif
#define GAS __attribute__((address_space(1)))
#define LAS __attribute__((address_space(3)))
typedef unsigned v4u __attribute__((ext_vector_type(4)));
typedef float f32x4 __attribute__((ext_vector_type(4)));
typedef short bf16x8 __attribute__((ext_vector_type(8)));
typedef GAS unsigned gu32;
#define RLX_AGENT __ATOMIC_RELAXED, __HIP_MEMORY_SCOPE_AGENT
#define LDS_WAIT() asm volatile("s_waitcnt lgkmcnt(0)" ::: "memory")

typedef WSM<C> WSMap;
typedef CtxT<C> Ctx;

namespace pg8 {
constexpr int BM = 256, BK = 64, HALF = 128, HTB = HALF * BK * 2, STAGE_BYTES = 8 * HTB;
__host__ __device__ __forceinline__ int lds_byte(int r, int c) { const int st = (r >> 4) * 2 + (c >> 5), rr = r & 15, cc = c & 31, ob = rr * 64 + cc * 2; return st * 1024 + (ob ^ (((ob >> 9) & 1) << 5)); }
__host__ __device__ __forceinline__ void stage_rc(int b, int& R, int& Cc) { const int st = b / 1024, sb = b % 1024, swz = sb ^ (((sb >> 9) & 1) << 5); R = (st >> 1) * 16 + swz / 64; Cc = (st & 1) * 32 + (swz % 64) / 2; }
__host__ __device__ __forceinline__ int perm32(int rho) { const int n = rho >> 4, i = rho & 15; return 8 * (i >> 2) + 4 * n + (i & 3); }
struct Unit { int pm, pn, tag; long aoff, boff; };
struct Gemm { const bf16* A; const bf16* Bt; int lda, ldb, K; };

template <class Epi, class Sched>
__device__ __forceinline__ void gemm_phase(LAS unsigned char* lds, const Gemm g, const Sched& S, const Epi& E, const int tid) {
    const int wid = __builtin_amdgcn_readfirstlane(tid >> 6), lane = tid & 63, wr = wid >> 2, wc = wid & 3, fr = lane & 15, fq = lane >> 4;
    const int K = g.K, nt = K / BK;
    unsigned voffA[2], voffB[2];
#pragma unroll
    for (int i = 0; i < 2; ++i) { int R, Cc; stage_rc(tid * 16 + i * 8192, R, Cc); const int Rb = (R & ~31) + perm32(R & 31); voffA[i] = (unsigned)(R * g.lda + Cc) * 2u; voffB[i] = (unsigned)(Rb * g.ldb + Cc) * 2u; }
    const size_t kstep = (size_t)(BK * 2);
    const size_t hstepA = (size_t)HALF * g.lda * 2, hstepB = (size_t)HALF * g.ldb * 2;
    const unsigned ldsw = (unsigned)wid * 1024u;
    const int aoff = lds_byte(wr * 64 + fr, fq * 8), boff = lds_byte(wc * 32 + fr, fq * 8);
#define PG8_SA(b, h) (((b) * 2 + (h)) * HTB)
#define PG8_SB(b, h) ((4 + (b) * 2 + (h)) * HTB)
#define PG8_STAGE(bufoff, gbase, voff) do { _Pragma("unroll") for (int _i = 0; _i < 2; ++_i) \
        __builtin_amdgcn_global_load_lds((const unsigned*)((const char*)(gbase) + (voff)[_i]), (LAS unsigned*)(lds + (bufoff) + ldsw + _i * 8192), 16, 0, 0); } while (0)
#define PG8_LDA(dst, b, h) do { _Pragma("unroll") for (int m = 0; m < 4; ++m) _Pragma("unroll") for (int k = 0; k < 2; ++k) dst[m][k] = *(const LAS bf16x8*)(lds + PG8_SA(b, h) + aoff + m * 2048 + k * 1024); } while (0)
#define PG8_LDB(dst, b, h) do { _Pragma("unroll") for (int n = 0; n < 2; ++n) _Pragma("unroll") for (int k = 0; k < 2; ++k) dst[n][k] = *(const LAS bf16x8*)(lds + PG8_SB(b, h) + boff + n * 2048 + k * 1024); } while (0)
#define PG8_MMA(ai, bj, At, Bt) do { __builtin_amdgcn_s_setprio(1); _Pragma("unroll") for (int m = 0; m < 4; ++m) _Pragma("unroll") for (int n = 0; n < 2; ++n) _Pragma("unroll") for (int k = 0; k < 2; ++k) \
        acc[ai][bj][m][n] = __builtin_amdgcn_mfma_f32_16x16x32_bf16(Bt[n][k], At[m][k], acc[ai][bj][m][n], 0, 0, 0); __builtin_amdgcn_s_setprio(0); } while (0)
#define PG8_WAIT_V(n) asm volatile("s_waitcnt vmcnt(" #n ")" ::: "memory")
#define PG8_WAIT_L(n) asm volatile("s_waitcnt lgkmcnt(" #n ")" ::: "memory")
#define PG8_BAR __builtin_amdgcn_s_barrier()
#define PG8_SCHED __builtin_amdgcn_sched_barrier(0)
    Unit cur, nxt; int ui = 0;
    if (!S.next(0, cur)) return;
    f32x4 acc[2][2][4][2];
#pragma unroll
    for (int a = 0; a < 2; ++a)
#pragma unroll
        for (int b = 0; b < 2; ++b)
#pragma unroll
            for (int m = 0; m < 4; ++m)
#pragma unroll
                for (int n = 0; n < 2; ++n) acc[a][b][m][n] = (f32x4){0.f, 0.f, 0.f, 0.f};
    bf16x8 At[4][2], B0[2][2], B1[2][2];
    const char* cA = (const char*)g.A + cur.aoff; const char* cB = (const char*)g.Bt + cur.boff;
    PG8_STAGE(PG8_SB(0, 0), cB, voffB); PG8_STAGE(PG8_SB(0, 1), cB + hstepB, voffB); PG8_STAGE(PG8_SA(0, 0), cA, voffA); PG8_STAGE(PG8_SA(0, 1), cA + hstepA, voffA);
    if (wr == 1) PG8_BAR;
    PG8_WAIT_V(2); PG8_BAR;
    PG8_STAGE(PG8_SB(1, 0), cB + kstep, voffB); PG8_STAGE(PG8_SA(1, 0), cA + kstep, voffA); PG8_STAGE(PG8_SB(1, 1), cB + hstepB + kstep, voffB);
    PG8_WAIT_V(6); PG8_BAR;
    for (;;) {
        const bool has_next = S.next(ui + 1, nxt);
        const char* nA = has_next ? (const char*)g.A + nxt.aoff : cA; const char* nB = has_next ? (const char*)g.Bt + nxt.boff : cB;
        for (int t = 0; t < nt; t += 2) {
            const bool last = (t == nt - 2);
            const char* a1 = cA + (size_t)(t + 1) * kstep;
            const char* a2 = last ? nA : cA + (size_t)(t + 2) * kstep; const char* b2 = last ? nB : cB + (size_t)(t + 2) * kstep;
            const char* a3 = a2 + kstep; const char* b3 = b2 + kstep;
            PG8_LDB(B0, 0, 0); PG8_LDB(B1, 0, 1); PG8_SCHED; PG8_LDA(At, 0, 0); PG8_STAGE(PG8_SA(1, 1), a1 + hstepA, voffA);
            PG8_WAIT_V(8); PG8_WAIT_L(0); PG8_BAR; PG8_MMA(0, 0, At, B0); PG8_MMA(0, 1, At, B1); PG8_BAR; PG8_SCHED;
            PG8_LDA(At, 0, 1); PG8_STAGE(PG8_SB(0, 0), b2, voffB); PG8_STAGE(PG8_SB(0, 1), b2 + hstepB, voffB); PG8_STAGE(PG8_SA(0, 0), a2, voffA);
            PG8_WAIT_V(8); PG8_WAIT_L(0); PG8_BAR; PG8_MMA(1, 0, At, B0); PG8_MMA(1, 1, At, B1); PG8_BAR; PG8_SCHED;
            PG8_LDB(B0, 1, 0); PG8_LDB(B1, 1, 1); PG8_SCHED; PG8_LDA(At, 1, 0); PG8_STAGE(PG8_SA(0, 1), a2 + hstepA, voffA);
            PG8_WAIT_V(8); PG8_WAIT_L(0); PG8_BAR; PG8_MMA(0, 0, At, B0); PG8_MMA(0, 1, At, B1); PG8_BAR; PG8_SCHED;
            PG8_LDA(At, 1, 1); PG8_STAGE(PG8_SB(1, 0), b3, voffB); PG8_STAGE(PG8_SB(1, 1), b3 + hstepB, voffB); PG8_STAGE(PG8_SA(1, 0), a3, voffA);
            PG8_WAIT_V(8); PG8_WAIT_L(0); PG8_BAR; PG8_MMA(1, 0, At, B0); PG8_MMA(1, 1, At, B1); PG8_BAR; PG8_SCHED;
        }
        if (wr == 0) PG8_BAR;
        const bool zero_acc = E(acc, cur, wr, wc, fr, fq);
        if (!has_next) break;
        if (zero_acc)
#pragma unroll
        for (int a = 0; a < 2; ++a)
#pragma unroll
            for (int b = 0; b < 2; ++b)
#pragma unroll
                for (int m = 0; m < 4; ++m)
#pragma unroll
                    for (int n = 0; n < 2; ++n) acc[a][b][m][n] = (f32x4){0.f, 0.f, 0.f, 0.f};
        cur = nxt; cA = nA; cB = nB; ++ui;
        if (wr == 1) PG8_BAR;
    }
    PG8_WAIT_V(0);
    PG8_BAR;
#undef PG8_SA
#undef PG8_SB
#undef PG8_STAGE
#undef PG8_LDA
#undef PG8_LDB
#undef PG8_MMA
#undef PG8_WAIT_V
#undef PG8_WAIT_L
#undef PG8_BAR
#undef PG8_SCHED
}
template <class E4> struct EpiWrap { E4 e;
    __device__ __forceinline__ void operator()(const f32x4 (&acc)[2][2][4][2], const Unit& u, int wr, int wc, int fr, int fq) const {
#pragma unroll
        for (int ai = 0; ai < 2; ++ai)
#pragma unroll
            for (int m = 0; m < 4; ++m)
#pragma unroll
                for (int bj = 0; bj < 2; ++bj)
#pragma unroll
                    for (int n = 0; n < 2; ++n) { const int row = u.pm * 256 + ai * 128 + wr * 64 + m * 16 + fr, col0 = u.pn * 256 + bj * 128 + wc * 32 + fq * 8 + n * 4;
                        const f32x4 a = acc[ai][bj][m][n]; const float v[4] = {a[0], a[1], a[2], a[3]}; e(u, row, col0, v); }
    }
};
struct RectSched {
    int G, c, nbr; int pm0_0, nM_0, pn0_0, nN_0, pm0_1, nM_1, pn0_1, nN_1; long lda2, ldb2, abr, bbr;
    bool blocked = false; int bm = 4, bn = 8;
    __device__ __forceinline__ bool next(int i, Unit& u) const {
        const int round = (nbr == 1) ? i : (i >> 2), br = (nbr == 1) ? 0 : (i & 3); int L = round * G + c;
        const int n0 = nM_0 * nN_0, n1 = nM_1 * nN_1;
        bool r = false; if (L >= n0) { L -= n0; r = true; if (L >= n1) return false; }
        const unsigned nm = (unsigned)(r ? nM_1 : nM_0); unsigned q = (unsigned)L / nm, rem = (unsigned)L - q * nm;
        const unsigned nn_ = (unsigned)nN_0; int bm_ = bm, bn_ = bn; if (nm % (unsigned)bm_ || nn_ % (unsigned)bn_) { bm_ = 4; bn_ = 8; }
        if (blocked && !r && nm % (unsigned)bm_ == 0 && nn_ % (unsigned)bn_ == 0) { const int bm = bm_, bn = bn_; const unsigned bsz = (unsigned)(bm * bn), blk = (unsigned)L / bsz, w = (unsigned)L - blk * bsz, nbm = nm / (unsigned)bm, bq = blk / nbm, br_ = blk - bq * nbm, wq = w / (unsigned)bm; rem = br_ * bm + (w - wq * bm); q = bq * bn + wq; }
        u.pm = (r ? pm0_1 : pm0_0) + (int)rem; u.pn = (r ? pn0_1 : pn0_0) + (int)q; u.tag = br;
        u.aoff = (long)u.pm * 256 * lda2 + br * abr; u.boff = (long)u.pn * 256 * ldb2 + br * bbr; return true;
    }
};
struct ChainSched {
    int G, c, nM, ntl, nsl, per; long lda2, ldb2, ksl;
    __device__ __forceinline__ bool next(int i, Unit& u) const {
        if (i >= per) return false;
        const unsigned q = (unsigned)(c * per + i), tile = q / (unsigned)nsl, sl = q - tile * (unsigned)nsl; if ((int)tile >= ntl) return false;
        const unsigned pn = tile / (unsigned)nM, pm = tile - pn * (unsigned)nM;
        u.pm = (int)pm; u.pn = (int)pn; u.aoff = (long)pm * 256 * lda2 + sl * ksl; u.boff = (long)pn * 256 * ldb2 + sl * ksl;
        const bool tile_end = (int)sl == nsl - 1, end = tile_end || i == per - 1, from0 = (int)(tile * (unsigned)nsl) >= c * per;
        u.tag = !end ? 0 : (from0 && tile_end) ? 1 : tile_end ? 2 : 3; return true;
    }
};
}

#define XB_TMO      128
#define XB_XCNT(j)  (256  + 64 * (j))
#define XB_XSUB(j)  (1280 + 64 * (j))
#define XB_XGEN(j)  (2304 + 64 * (j))
#define XB_TOP      3328
#define XB_TOPGEN   3392
#define XCD_BAR_WORDS 3456
#define XB_SPIN_CAP (1u << 18)
__device__ __forceinline__ unsigned xb_ld(unsigned* p)              { return __hip_atomic_load(p, __ATOMIC_RELAXED, __HIP_MEMORY_SCOPE_AGENT); }
__device__ __forceinline__ unsigned xb_add(unsigned* p, unsigned v) { return __hip_atomic_fetch_add(p, v, __ATOMIC_RELAXED, __HIP_MEMORY_SCOPE_AGENT); }
__device__ __forceinline__ unsigned xb_xcc_id() { return (unsigned)__builtin_amdgcn_s_getreg((3 << 11) | 20) & 0xFu; }
#define XB_SPIN(cond, bar) do { unsigned _sp = 0; while (cond) { __builtin_amdgcn_s_sleep(1); \
    if ((++_sp & 255u) == 0u) { if (xb_ld(&(bar)[XB_TMO])) break; if (_sp > XB_SPIN_CAP) { atomicAdd(&(bar)[XB_TMO], 1u); break; } } } } while (0)
struct XcdBarrier { unsigned* bar; unsigned x; volatile LAS unsigned* st; unsigned members; };
__device__ __forceinline__ XcdBarrier xcd_barrier_post(unsigned* bar, volatile LAS unsigned* st, unsigned members, bool member) {
    XcdBarrier b; b.bar = bar; b.x = xb_xcc_id(); b.st = st; b.members = members;
    if (!member) return b;
    if (threadIdx.x == 0) (void)xb_add(&bar[XB_XCNT(b.x)], 1u);
    return b;
}
__device__ __forceinline__ void xcd_barrier_complete(unsigned* bar, unsigned x, unsigned G, unsigned& nloc, unsigned& nx) {
    unsigned sum, cnt, mine, sp = 0u;
    for (;;) {
        sum = 0u; cnt = 0u; mine = 0u;
#pragma unroll
        for (unsigned j = 0; j < 16; ++j) { const unsigned c = xb_ld(&bar[XB_XCNT(j)]); sum += c; cnt += (c > 0u) ? 1u : 0u; mine = (j == x) ? c : mine; }
        if (sum == G) break;
        __builtin_amdgcn_s_sleep(1);
        if ((++sp & 255u) == 0u) { if (xb_ld(&bar[XB_TMO])) break; if (sp > XB_SPIN_CAP) { atomicAdd(&bar[XB_TMO], 1u); break; } }
    }
    nloc = mine > 0u ? mine : 1u; nx = cnt > 0u ? cnt : 1u;
}
__device__ __forceinline__ void xcd_barrier(const XcdBarrier& b) {
    asm volatile("s_waitcnt vmcnt(0)" ::: "memory");
    __syncthreads();
    if (threadIdx.x == 0) {
        unsigned* bar = b.bar; unsigned bx_ = b.x; asm volatile("" : "+s"(bx_));
        __builtin_amdgcn_s_waitcnt(0);
        unsigned nloc = b.st[0], nx = b.st[1];
        if (nloc == 0u) { xcd_barrier_complete(bar, bx_, b.members, nloc, nx); b.st[0] = nloc; b.st[1] = nx; }
        const unsigned old = xb_add(&bar[XB_XSUB(bx_)], 1u);
        const unsigned gen = old / nloc;
        if (old + 1u == (gen + 1u) * nloc) {
            __builtin_amdgcn_fence(__ATOMIC_RELEASE, "agent");
            asm volatile("s_waitcnt vmcnt(0)" ::: "memory");
            const unsigned og = xb_add(&bar[XB_TOP], 1u);
            const unsigned tg = og / nx;
            if (og + 1u == (tg + 1u) * nx) xb_add(&bar[XB_TOPGEN], 1u);
            else XB_SPIN(xb_ld(&bar[XB_TOPGEN]) == tg, bar);
            __builtin_amdgcn_fence(__ATOMIC_ACQUIRE, "agent");
            xb_add(&bar[XB_XGEN(bx_)], 1u);
            asm volatile("s_waitcnt vmcnt(0)" ::: "memory");
        } else {
            XB_SPIN(xb_ld(&bar[XB_XGEN(bx_)]) == gen, bar);
            __builtin_amdgcn_fence(__ATOMIC_ACQUIRE, "agent");
            asm volatile("s_waitcnt vmcnt(0)" ::: "memory");
        }
    }
    __syncthreads();
}

constexpr int NWAVES = 8, NTHR = 512;
constexpr int RING_BYTES = 131072, LDSCTL_OFF = RING_BYTES, MISC_OFF = LDSCTL_OFF + 320, LDS_BYTES = 147456;
constexpr int CW_BAR = 4096, CW_FLAGS = 16384, FLAG_BANK = 288 * 64;

__device__ __forceinline__ unsigned pk2(float lo, float hi) { return (unsigned)f2bf(lo) | ((unsigned)f2bf(hi) << 16); }
__device__ __forceinline__ void transpose_item(const float* W, int K, int N, bf16* WT, int row_off, LAS float* scr, int item, int lane) {
    const int nblk = N / 32, kb = item / nblk, nb = item % nblk, k0 = 64 * kb, n0 = 32 * nb;
#pragma unroll 8
    for (int i = 0; i < 32; ++i) { const int kk = 2 * i + (lane >> 5); scr[kk * 33 + (lane & 31)] = W[(size_t)(k0 + kk) * N + n0 + (lane & 31)]; }
    LDS_WAIT(); asm volatile("" ::: "memory");
    const int c = lane & 7;
#pragma unroll
    for (int j = 0; j < 4; ++j) { const int n = (lane >> 3) + 8 * j; const LAS float* s = scr + (8 * c) * 33 + n;
        v4u o; o.x = pk2(s[0 * 33], s[1 * 33]); o.y = pk2(s[2 * 33], s[3 * 33]); o.z = pk2(s[4 * 33], s[5 * 33]); o.w = pk2(s[6 * 33], s[7 * 33]);
        *(GAS v4u*)(WT + (size_t)(row_off + n0 + n) * K + k0 + 8 * c) = o; }
    LDS_WAIT(); asm volatile("" ::: "memory");
}
__device__ __forceinline__ void transpose_item64(const float* W, int K, int N, bf16* WT, LAS float* scr, int item, int lane) {
    const int nblk = N / 64, kb = item / nblk, nb = item - kb * nblk, k0 = 64 * kb, n0 = 64 * nb;
    const float* src = W + (size_t)(k0 + (lane >> 4)) * N + n0 + (lane & 15) * 4;
    f32x4 v[16];
#pragma unroll
    for (int i = 0; i < 16; ++i) v[i] = *(const f32x4*)(src + (size_t)(4 * i) * N);
#pragma unroll
    for (int i = 0; i < 16; ++i) { const int kk = 4 * i + (lane >> 4); *(LAS f32x4*)(scr + kk * 64 + (((lane & 15) * 4 + 4 * (kk >> 3)) & 63)) = v[i]; }
    LDS_WAIT(); asm volatile("" ::: "memory");
    const int c = lane & 7;
#pragma unroll
    for (int j = 0; j < 8; ++j) { const int n = (lane >> 3) + 8 * j; const LAS float* s = scr + (8 * c) * 64 + ((n + 4 * c) & 63);
        v4u o; o.x = pk2(s[0 * 64], s[1 * 64]); o.y = pk2(s[2 * 64], s[3 * 64]); o.z = pk2(s[4 * 64], s[5 * 64]); o.w = pk2(s[6 * 64], s[7 * 64]);
        *(GAS v4u*)(WT + (size_t)(n0 + n) * K + k0 + 8 * c) = o; }
    LDS_WAIT(); asm volatile("" ::: "memory");
}
__device__ __forceinline__ float wave_sum(float v) {
#pragma unroll
    for (int o = 1; o < 64; o <<= 1) v += __shfl_xor(v, o);
    return v;
}

typedef float f32x2_t __attribute__((ext_vector_type(2))); typedef __bf16 bf16x2_t __attribute__((ext_vector_type(2)));
typedef unsigned u32x2 __attribute__((ext_vector_type(2)));
__device__ __forceinline__ unsigned cvtpk(float lo, float hi) { f32x2_t v = {lo, hi}; bf16x2_t b = __builtin_convertvector(v, bf16x2_t); return __builtin_bit_cast(unsigned, b); }
__device__ __forceinline__ float fast_sigmoid(float x) { return __builtin_amdgcn_rcpf(1.0f + __builtin_amdgcn_exp2f(-1.4426950408889634f * x)); }
__device__ __forceinline__ float fexp(float x) { return __builtin_amdgcn_exp2f(x * 1.4426950408889634f); }
__device__ __forceinline__ float flog(float x) { return __builtin_amdgcn_logf(x) * 0.6931471805599453f; }
__device__ __forceinline__ float ftanh(float x) { return 1.0f - 2.0f * __builtin_amdgcn_rcpf(1.0f + fexp(2.0f * x)); }
__device__ __forceinline__ float bflo(unsigned w) { return __builtin_bit_cast(float, w << 16); }
__device__ __forceinline__ float bfhi(unsigned w) { return __builtin_bit_cast(float, w & 0xffff0000u); }
#define EPI_LOOP(...) \
    _Pragma("unroll") for (int ai = 0; ai < 2; ++ai) _Pragma("unroll") for (int m = 0; m < 4; ++m) { const int row = u.pm * 256 + ai * 128 + wr * 64 + m * 16 + fr; \
        _Pragma("unroll") for (int bj = 0; bj < 2; ++bj) _Pragma("unroll") for (int n = 0; n < 2; ++n) { const int col0 = u.pn * 256 + bj * 128 + wc * 32 + fq * 8 + n * 4; f32x4 v = acc[ai][bj][m][n]; __VA_ARGS__ } \
        asm volatile("" ::: "memory"); }
#define EPI_LOOP8(...) \
    _Pragma("unroll") for (int ai = 0; ai < 2; ++ai) _Pragma("unroll") for (int m = 0; m < 4; ++m) { const int row = u.pm * 256 + ai * 128 + wr * 64 + m * 16 + fr; \
        _Pragma("unroll") for (int bj = 0; bj < 2; ++bj) { const int col0 = u.pn * 256 + bj * 128 + wc * 32 + fq * 8; f32x4 v0 = acc[ai][bj][m][0], v1 = acc[ai][bj][m][1]; __VA_ARGS__ } \
        asm volatile("" ::: "memory"); }
struct DEpiPX { bf16* PX; const float* ROPE; bf16* KR;
    __device__ __forceinline__ bool operator()(f32x4 (&acc)[2][2][4][2], const pg8::Unit& u, int wr, int wc, int fr, int fq) const {
        const bool lat = u.pm * 256 < C::MX;
        EPI_LOOP8({ if (col0 >= C::O_GATE) {
                _Pragma("unroll") for (int e = 0; e < 4; ++e) { v0[e] = fmaxf(fast_sigmoid(v0[e]), 1e-6f); v1[e] = fmaxf(fast_sigmoid(v1[e]), 1e-6f); } }
            else if (lat && ((col0 >= C::O_KV && col0 < C::O_KV + C::AKVW) || (col0 >= C::O_Q && col0 < C::O_Q + C::BW))) {
                const int d = (col0 - (col0 >= C::O_Q ? C::O_Q : C::O_KV)) & (C::AH - 1), half = d >> 5, dp = d & 31, i0 = dp & 15; const bool first = dp < 16;
                const float* rp = ROPE + ((size_t)(row % C::S) * (C::AH / 2) + half * (C::AH / 4) + i0) * 2;
                const f32x4 c0 = *(const f32x4*)(rp), c1 = *(const f32x4*)(rp + 4), c2 = *(const f32x4*)(rp + 8), c3 = *(const f32x4*)(rp + 12);
                f32x4 p0, p1;
                _Pragma("unroll") for (int e = 0; e < 4; ++e) { p0[e] = __shfl_xor(v0[e], 32); p1[e] = __shfl_xor(v1[e], 32); }
                const float sg = first ? -1.0f : 1.0f;
                v0[0] = v0[0] * c0[0] + sg * p0[0] * c0[1]; v0[1] = v0[1] * c0[2] + sg * p0[1] * c0[3]; v0[2] = v0[2] * c1[0] + sg * p0[2] * c1[1]; v0[3] = v0[3] * c1[2] + sg * p0[3] * c1[3];
                v1[0] = v1[0] * c2[0] + sg * p1[0] * c2[1]; v1[1] = v1[1] * c2[2] + sg * p1[1] * c2[3]; v1[2] = v1[2] * c3[0] + sg * p1[2] * c3[1]; v1[3] = v1[3] * c3[2] + sg * p1[3] * c3[3]; }
            v4u w; w.x = cvtpk(v0[0], v0[1]); w.y = cvtpk(v0[2], v0[3]); w.z = cvtpk(v1[0], v1[1]); w.w = cvtpk(v1[2], v1[3]);
            if (col0 >= C::O_KV && col0 < C::O_KV + C::AKVW) *(v4u*)(KR + (unsigned)(row * C::AKVW + (col0 - C::O_KV))) = w; else *(v4u*)(PX + (unsigned)(row * C::PXW + col0)) = w; })
        return true;
    } };
struct DEpiMerge { const bf16* PX; bf16* MIX;
    __device__ __forceinline__ bool operator()(f32x4 (&acc)[2][2][4][2], const pg8::Unit& u, int wr, int wc, int fr, int fq) const {
        const int i = u.tag;
#pragma unroll
        for (int ai = 0; ai < 2; ++ai) {
            v4u gt[4][2], pr[4][2];
#pragma unroll
            for (int m = 0; m < 4; ++m) { const int row = u.pm * 256 + ai * 128 + wr * 64 + m * 16 + fr;
#pragma unroll
                for (int bj = 0; bj < 2; ++bj) { const int col0 = u.pn * 256 + bj * 128 + wc * 32 + fq * 8;
                    gt[m][bj] = *(const v4u*)(PX + (unsigned)(row * C::PXW + C::O_GATE + i * C::D + col0));
                    if (i > 0) pr[m][bj] = *(const v4u*)(MIX + (unsigned)(row * C::D + col0)); } }
#pragma unroll
            for (int m = 0; m < 4; ++m) { const int row = u.pm * 256 + ai * 128 + wr * 64 + m * 16 + fr;
#pragma unroll
                for (int bj = 0; bj < 2; ++bj) { const int col0 = u.pn * 256 + bj * 128 + wc * 32 + fq * 8; f32x4 v0 = acc[ai][bj][m][0], v1 = acc[ai][bj][m][1]; const v4u g = gt[m][bj];
                    v0[0] *= bflo(g.x); v0[1] *= bfhi(g.x); v0[2] *= bflo(g.y); v0[3] *= bfhi(g.y); v1[0] *= bflo(g.z); v1[1] *= bfhi(g.z); v1[2] *= bflo(g.w); v1[3] *= bfhi(g.w);
                    if (i > 0) { const v4u q = pr[m][bj]; v0[0] += bflo(q.x); v0[1] += bfhi(q.x); v0[2] += bflo(q.y); v0[3] += bfhi(q.y); v1[0] += bflo(q.z); v1[1] += bfhi(q.z); v1[2] += bflo(q.w); v1[3] += bfhi(q.w); }
                    v4u w; w.x = cvtpk(v0[0], v0[1]); w.y = cvtpk(v0[2], v0[3]); w.z = cvtpk(v1[0], v1[1]); w.w = cvtpk(v1[2], v1[3]); *(v4u*)(MIX + (unsigned)(row * C::D + col0)) = w; } }
            asm volatile("" ::: "memory");
        }
        return true;
    } };
struct DEpiRes { float* X; const float* MODg; const float* xin; const float* cin;
    __device__ __forceinline__ bool operator()(f32x4 (&acc)[2][2][4][2], const pg8::Unit& u, int wr, int wc, int fr, int fq) const {
        const float* XS = xin ? (u.pm * 256 < C::MX ? xin : cin - (size_t)C::MX * C::D) : X;
        f32x4 g[2][2];
        { const float* gp = MODg + (unsigned)(mod_row<C>(u.pm * 256) * 6 * C::D + u.pn * 256 + wc * 32 + fq * 8);
#pragma unroll
          for (int bj = 0; bj < 2; ++bj)
#pragma unroll
            for (int n = 0; n < 2; ++n) g[bj][n] = *(const f32x4*)(gp + bj * 128 + n * 4); }
#pragma unroll
        for (int ai = 0; ai < 2; ++ai)
#pragma unroll
          for (int mp = 0; mp < 2; ++mp) {
            f32x4 x[2][2][2];
#pragma unroll
            for (int mm = 0; mm < 2; ++mm) { const int row = u.pm * 256 + ai * 128 + wr * 64 + (2 * mp + mm) * 16 + fr; const float* xp = XS + (unsigned)(row * C::D + u.pn * 256 + wc * 32 + fq * 8);
#pragma unroll
                for (int bj = 0; bj < 2; ++bj)
#pragma unroll
                    for (int n = 0; n < 2; ++n) x[mm][bj][n] = *(const f32x4*)(xp + bj * 128 + n * 4); }
#pragma unroll
            for (int mm = 0; mm < 2; ++mm) { const int row = u.pm * 256 + ai * 128 + wr * 64 + (2 * mp + mm) * 16 + fr; float* xp = X + (unsigned)(row * C::D + u.pn * 256 + wc * 32 + fq * 8);
#pragma unroll
                for (int bj = 0; bj < 2; ++bj)
#pragma unroll
                    for (int n = 0; n < 2; ++n) *(f32x4*)(xp + bj * 128 + n * 4) = x[mm][bj][n] + g[bj][n] * acc[ai][bj][2 * mp + mm][n]; }
            asm volatile("" ::: "memory");
          }
        return true;
    } };
struct DEpiResChain { float* X; const float* MODg; unsigned* flags; int nM; const float* xin; const float* cin;
    __device__ __forceinline__ bool operator()(f32x4 (&acc)[2][2][4][2], const pg8::Unit& u, int wr, int wc, int fr, int fq) const {
        if (u.tag == 0) return false;
        unsigned* flag = flags + 64 * (u.pn * nM + u.pm);
        if (u.tag == 3) {
            unsigned spins = 0; while (__hip_atomic_load(flag, __ATOMIC_RELAXED, __HIP_MEMORY_SCOPE_AGENT) == 0u && ++spins < (1u << 22)) __builtin_amdgcn_s_sleep(2);
            __builtin_amdgcn_fence(__ATOMIC_ACQUIRE, "agent"); asm volatile("s_waitcnt vmcnt(0)" ::: "memory");
        }
        DEpiRes inner{X, MODg, u.tag == 3 ? nullptr : xin, cin}; inner(acc, u, wr, wc, fr, fq);
        if (u.tag == 2) {
            asm volatile("s_waitcnt vmcnt(0)" ::: "memory"); __builtin_amdgcn_s_barrier(); asm volatile("" ::: "memory");
            if (threadIdx.x == 0) { __builtin_amdgcn_fence(__ATOMIC_RELEASE, "agent"); asm volatile("s_waitcnt vmcnt(0)" ::: "memory"); __hip_atomic_store(flag, 1u, __ATOMIC_RELAXED, __HIP_MEMORY_SCOPE_AGENT); }
        }
        return true;
    } };
struct DEpiMlp1 { bf16* U;
    __device__ __forceinline__ bool operator()(f32x4 (&acc)[2][2][4][2], const pg8::Unit& u, int wr, int wc, int fr, int fq) const {
        EPI_LOOP8({
            _Pragma("unroll") for (int e = 0; e < 4; ++e) { v0[e] = v0[e] > 0.f ? v0[e] * v0[e] : 0.f; v1[e] = v1[e] > 0.f ? v1[e] * v1[e] : 0.f; }
            v4u w; w.x = cvtpk(v0[0], v0[1]); w.y = cvtpk(v0[2], v0[3]); w.z = cvtpk(v1[0], v1[1]); w.w = cvtpk(v1[2], v1[3]); *(v4u*)(U + (unsigned)(row * C::HID + col0)) = w; })
        return true;
    } };
struct DEpiFno { bf16* FEATS; int L, row0;
    __device__ __forceinline__ bool operator()(f32x4 (&acc)[2][2][4][2], const pg8::Unit& u, int wr, int wc, int fr, int fq) const {
        EPI_LOOP({ const int b = col0 / C::BW, nn = col0 % C::BW; u32x2 w; w.x = cvtpk(v[0], v[1]); w.y = cvtpk(v[2], v[3]);
            *(u32x2*)(FEATS + (unsigned)((row0 + b * L + row) * C::D + nn)) = w; })
        return true;
    } };

constexpr int PS_NSTEP = C::CT + C::S, PS_STEPF = 6 * C::RH;
__device__ __forceinline__ size_t ps_off(int d, int b, int h, int s) { return ((((size_t)d * C::B + b) * C::RNH + h) * PS_NSTEP + s) * PS_STEPF; }
__device__ __forceinline__ int ps_step(int d, bool isc, int t) { return isc ? (d == 0 ? t : C::CT - 1 - t) : C::CT + (d == 0 ? t : C::S - 1 - t); }
constexpr int PREP_ROWS = 32;
__device__ __forceinline__ void prep_phase(const Ctx& c, int l, LAS unsigned char* lds, int tid, int vcu, int G) {
    LAS float* ft = (LAS float*)lds;
    const int ch = tid, h = tid >> 6, cl = tid & 63;
    constexpr int NCH = C::MA / PREP_ROWS;
    float* PS = c.PR();
    for (int unit = vcu; unit < 2 * NCH; unit += G) {
        const int d = unit / NCH, chunk = unit % NCH, row0 = chunk * PREP_ROWS;
        int b, t0, L, base; bool isc; row_info<C>(row0, b, t0, L, base, isc);
        const float* mu = c.mu() + ((size_t)l * 2 + d) * C::SHW;
        const int dt = d == 0 ? 1 : -1;
        { const int fi = tid & 127, lcol = C::O_LORA + d * C::DLW + fi; const float mu_l = mu[3 * C::BW + fi];
#pragma unroll
          for (int q = 0; q < PREP_ROWS / 4; ++q) { const int i = (tid >> 7) + 4 * q, t = t0 + i, tp = t - dt;
              const float fl = bf2f(c.PX()[(size_t)(base + t) * C::PXW + lcol]); const float pl = (tp >= 0 && tp < L) ? bf2f(c.PX()[(size_t)(base + tp) * C::PXW + lcol]) : 0.f;
              const float m = fl + mu_l * (pl - fl); ft[i * 128 + fi] = fi < C::DL ? ftanh(m) : m; } }
        __syncthreads();
        float wreg[C::DL];
#pragma unroll
        for (int j = 0; j < C::DL; ++j) wreg[j] = (c.w_up() + (((size_t)l * 2 + d) * C::DL + j) * C::BW)[(unsigned)ch];
        { const float w0 = c.w0()[((size_t)l * 2 + d) * C::BW + ch];
#pragma unroll 1
          for (int i = 0; i < PREP_ROWS; ++i) { float wr = w0;
#pragma unroll
              for (int j = 0; j < C::DL; j += 4) { const f32x4 x = *(const LAS f32x4*)(ft + i * 128 + j); wr += x[0] * wreg[j] + x[1] * wreg[j + 1] + x[2] * wreg[j + 2] + x[3] * wreg[j + 3]; }
              const float z = -wr; const float sp = (z > 0.f ? z : 0.f) + flog(1.0f + fexp(-fabsf(z)));
              PS[ps_off(d, b, h, ps_step(d, isc, t0 + i)) + C::RH + cl] = fexp(-fexp(-sp - 0.5f)); } }
#pragma unroll
        for (int j = 0; j < C::AL; ++j) wreg[j] = (c.a_up() + (((size_t)l * 2 + d) * C::AL + j) * C::BW)[(unsigned)ch];
        { const float mu_r = mu[ch], mu_k = mu[C::BW + ch], mu_v = mu[2 * C::BW + ch];
          const float a0 = c.a0()[((size_t)l * 2 + d) * C::BW + ch], kkw = c.k_k()[l * C::BW + ch], kaw = c.k_a()[l * C::BW + ch];
          const int tfirst = d == 0 ? t0 : t0 + PREP_ROWS - 1, tprev = tfirst - dt;
          float pr = 0.f, pk = 0.f, pv = 0.f;
          if (tprev >= 0 && tprev < L) { const bf16* p = c.PX() + (size_t)(base + tprev) * C::PXW; pr = bf2f(p[ch]); pk = bf2f(p[C::BW + ch]); pv = bf2f(p[2 * C::BW + ch]); }
          bf16 nr, nk, nv;
          { const bf16* p = c.PX() + (size_t)(base + tfirst) * C::PXW; nr = p[ch]; nk = p[C::BW + ch]; nv = p[2 * C::BW + ch]; }
#pragma unroll 1
          for (int i = 0; i < PREP_ROWS; ++i) {
              const int t = tfirst + dt * i;
              const float fr_ = bf2f(nr), fk_ = bf2f(nk), fv_ = bf2f(nv);
              if (i + 1 < PREP_ROWS) { const bf16* p = c.PX() + (size_t)(base + t + dt) * C::PXW; nr = p[ch]; nk = p[C::BW + ch]; nv = p[2 * C::BW + ch]; }
              const float r = fr_ + mu_r * (pr - fr_), k = fk_ + mu_k * (pk - fk_), v = fv_ + mu_v * (pv - fv_);
              pr = fr_; pk = fk_; pv = fv_;
              float ar = a0; const LAS float* fp = ft + (t - t0) * 128 + C::DL;
#pragma unroll
              for (int j = 0; j < C::AL; j += 4) { const f32x4 x = *(const LAS f32x4*)(fp + j); ar += x[0] * wreg[j] + x[1] * wreg[j + 1] + x[2] * wreg[j + 2] + x[3] * wreg[j + 3]; }
              const float a = fast_sigmoid(ar);
              const float kv = k * kkw; const float ss = wave_sum(kv * kv); const float nrm = sqrtf(ss);
              const float kk = kv * __builtin_amdgcn_rcpf(nrm > 1e-12f ? nrm : 1e-12f); const float krep = k * (1.0f + (a - 1.0f) * kaw);
              float* o = PS + ps_off(d, b, h, ps_step(d, isc, t)) + cl;
              o[0] = kk; o[2 * C::RH] = kk * a; o[3 * C::RH] = krep; o[4 * C::RH] = r; o[5 * C::RH] = v;
          } }
        __syncthreads();
    }
}
constexpr int RO_ROWS = 16;
struct RoIn { float y0, y1, r0, k0, v0, r1, k1, v1; bf16 gi; };
__device__ __forceinline__ RoIn ro_load(const Ctx& c, int row, int ch, int tid) {
    int b, t, L, base; bool isc; row_info<C>(row, b, t, L, base, isc);
    const int h = ch >> 6, cl = ch & 63; const float* PS = c.PR();
    const float* p0 = PS + ps_off(0, b, h, ps_step(0, isc, t)) + cl; const float* p1 = PS + ps_off(1, b, h, ps_step(1, isc, t)) + cl;
    RoIn x; x.y0 = c.Y()[(size_t)row * C::BW + ch]; x.y1 = c.Y()[((size_t)C::MA + row) * C::BW + ch];
    x.r0 = p0[4 * C::RH]; x.k0 = p0[3 * C::RH]; x.v0 = p0[5 * C::RH]; x.r1 = p1[4 * C::RH]; x.k1 = p1[3 * C::RH]; x.v1 = p1[5 * C::RH];
    x.gi = c.PX()[(size_t)row * C::PXW + C::O_G + (tid < C::GL ? tid : 0)]; return x;
}
__device__ __forceinline__ void readout_phase(const Ctx& c, int l, int nrows, LAS unsigned char* lds, int tid, int vcu, int G) {
    LAS float* lb = (LAS float*)lds;
    const int ch = tid, h = tid >> 6;
    float greg[C::GL];
#pragma unroll
    for (int j = 0; j < C::GL; ++j) greg[j] = (c.g_up() + ((size_t)l * C::GL + j) * C::BW)[(unsigned)ch];
    const float lg = c.lnx_g()[l * C::BW + ch], lbb = c.lnx_b()[l * C::BW + ch];
    const float rk0 = c.r_k()[(((size_t)l * 2 + 0) * C::RNH + h) * C::RH + (ch & 63)], rk1 = c.r_k()[(((size_t)l * 2 + 1) * C::RNH + h) * C::RH + (ch & 63)];
    int cur = 0;
    for (int unit = vcu; unit < nrows / RO_ROWS; unit += G) {
        RoIn nx = ro_load(c, unit * RO_ROWS, ch, tid);
        for (int i = 0; i < RO_ROWS; ++i) {
            const int row = unit * RO_ROWS + i; const RoIn x = nx;
            if (i + 1 < RO_ROWS) nx = ro_load(c, row + 1, ch, tid);
            if (tid < C::GL) lb[cur * 128 + tid] = fast_sigmoid(bf2f(x.gi));
            const float y = x.y0 + x.y1;
            const float mean = wave_sum(y) * (1.0f / C::RH); const float dv = y - mean; const float var = wave_sum(dv * dv) * (1.0f / C::RH);
            const float yn = dv * __builtin_amdgcn_rsqf(var + 64e-5f) * lg + lbb;
            const float s0 = wave_sum(x.r0 * x.k0 * rk0), s1 = wave_sum(x.r1 * x.k1 * rk1);
            const float bonus = s0 * x.v0 + s1 * x.v1;
            __syncthreads();
            float g = 0.f;
#pragma unroll
            for (int j = 0; j < C::GL; j += 4) { const f32x4 xx = *(const LAS f32x4*)(lb + cur * 128 + j); g += xx[0] * greg[j] + xx[1] * greg[j + 1] + xx[2] * greg[j + 2] + xx[3] * greg[j + 3]; if ((j & 12) == 12) asm volatile("" ::: "memory"); }
            c.FEATS()[(size_t)row * C::D + C::BW + ch] = f2bf((yn + bonus) * g);
            cur ^= 1;
        }
    }
    __syncthreads();
}
typedef float f32x16 __attribute__((ext_vector_type(16)));
typedef short s16x4 __attribute__((ext_vector_type(4)));
constexpr int AT_KSTR = 144, AT_VSTR = 648, AT_KOFF = 0, AT_VOFF = 320 * AT_KSTR;
__device__ __forceinline__ void attn_unit(const Ctx& c, int l, LAS unsigned char* lds, int tid, int b, int g, int qrow0, int tq0, bool ctxq) {
    const int lane = tid & 63, wave = __builtin_amdgcn_readfirstlane(tid >> 6), hl = wave >> 1, qh = wave & 1, ql = lane & 31, hi = lane >> 5;
    const int h = g * C::AREP + hl, qrow = qrow0 + 32 * qh + ql, tq = tq0 + 32 * qh + ql;
    bf16x8 qf[4];
#pragma unroll
    for (int s_ = 0; s_ < 4; ++s_) qf[s_] = *(const bf16x8*)(c.PX() + (size_t)qrow * C::PXW + C::O_Q + h * C::AH + 16 * s_ + 8 * hi);
    float m = c.sink()[l * C::ANH + h], lsum = hi == 0 ? 1.0f : 0.0f;
    f32x16 o0 = {}, o1 = {};
    const int npass = ctxq ? 1 : 2;
    for (int pass = 0; pass < npass; ++pass) {
        const int nk = pass == 0 ? C::CT : 2 * C::WIN + 64; const int jbase = tq0 - C::WIN;
        for (int it = tid; it < nk * 8; it += NTHR) {
            const int key = it >> 3, chn = it & 7; int row; bool valid = true;
            if (pass == 0) row = C::MX + b * C::CT + key; else { const int j = jbase + key; valid = j >= 0 && j < C::S; row = b * C::S + j; }
            v4u val = {0u, 0u, 0u, 0u};
            if (valid) val = *(const v4u*)(c.KR() + (size_t)row * C::AKVW + g * C::AH + chn * 8);
            *(LAS v4u*)(lds + AT_KOFF + key * AT_KSTR + chn * 16) = val;
        }
        for (int it = tid; it < nk * 8; it += NTHR) {
            const int dch = it / nk, key = it - dch * nk; int row; bool valid = true;
            if (pass == 0) row = C::MX + b * C::CT + key; else { const int j = jbase + key; valid = j >= 0 && j < C::S; row = b * C::S + j; }
            v4u val = {0u, 0u, 0u, 0u};
            if (valid) val = *(const v4u*)(c.PX() + (size_t)row * C::PXW + C::O_KV + C::AKVW + g * C::AH + dch * 8);
            LAS unsigned short* vt = (LAS unsigned short*)(lds + AT_VOFF) + (dch * 8) * (AT_VSTR / 2) + key;
            vt[0 * (AT_VSTR / 2)] = (unsigned short)(val.x & 0xffffu); vt[1 * (AT_VSTR / 2)] = (unsigned short)(val.x >> 16);
            vt[2 * (AT_VSTR / 2)] = (unsigned short)(val.y & 0xffffu); vt[3 * (AT_VSTR / 2)] = (unsigned short)(val.y >> 16);
            vt[4 * (AT_VSTR / 2)] = (unsigned short)(val.z & 0xffffu); vt[5 * (AT_VSTR / 2)] = (unsigned short)(val.z >> 16);
            vt[6 * (AT_VSTR / 2)] = (unsigned short)(val.w & 0xffffu); vt[7 * (AT_VSTR / 2)] = (unsigned short)(val.w >> 16);
        }
        __syncthreads();
        const int qa = tq0 + 32 * qh;
        for (int kt = 0; kt < nk / 32; ++kt) {
            const int jb = jbase + 32 * kt;
            if (pass == 1 && (jb + 31 < qa - C::WIN || jb > qa + 31 + C::WIN)) continue;
            f32x16 sacc = {};
#pragma unroll
            for (int s_ = 0; s_ < 4; ++s_) { const bf16x8 kf = *(const LAS bf16x8*)(lds + AT_KOFF + (32 * kt + ql) * AT_KSTR + (16 * s_ + 8 * hi) * 2);
                sacc = __builtin_amdgcn_mfma_f32_32x32x16_bf16(kf, qf[s_], sacc, 0, 0, 0); }
            float mx = -1e30f;
#pragma unroll
            for (int r = 0; r < 16; ++r) { float sv = sacc[r] * 0.125f;
                if (pass == 1) { const int j = jb + (r & 3) + 8 * (r >> 2) + 4 * hi; const int dj = j - tq; if (j < 0 || j >= C::S || dj > C::WIN || dj < -C::WIN) sv = -1e30f; }
                sacc[r] = sv; mx = fmaxf(mx, sv); }
            mx = fmaxf(mx, __shfl_xor(mx, 32));
            const float mn = fmaxf(m, mx), f = __builtin_amdgcn_exp2f((m - mn) * 1.4426950408889634f); m = mn;
            float ps = 0.f;
#pragma unroll
            for (int r = 0; r < 16; ++r) { const float p = __builtin_amdgcn_exp2f((sacc[r] - mn) * 1.4426950408889634f); sacc[r] = p; ps += p; }
            lsum = lsum * f + ps;
#pragma unroll
            for (int r = 0; r < 16; ++r) { o0[r] *= f; o1[r] *= f; }
            bf16x8 pb[2];
#pragma unroll
            for (int s_ = 0; s_ < 2; ++s_) { v4u w; w.x = cvtpk(sacc[8 * s_ + 0], sacc[8 * s_ + 1]); w.y = cvtpk(sacc[8 * s_ + 2], sacc[8 * s_ + 3]); w.z = cvtpk(sacc[8 * s_ + 4], sacc[8 * s_ + 5]); w.w = cvtpk(sacc[8 * s_ + 6], sacc[8 * s_ + 7]);
                pb[s_] = __builtin_bit_cast(bf16x8, w); }
#pragma unroll
            for (int s_ = 0; s_ < 2; ++s_) {
                const LAS unsigned char* vp = lds + AT_VOFF + ql * AT_VSTR + (32 * kt + 16 * s_ + 4 * hi) * 2;
                const s16x4 a0 = *(const LAS s16x4*)(vp), a1 = *(const LAS s16x4*)(vp + 16);
                const s16x4 b0 = *(const LAS s16x4*)(vp + 32 * AT_VSTR), b1 = *(const LAS s16x4*)(vp + 32 * AT_VSTR + 16);
                const bf16x8 va0 = {a0[0], a0[1], a0[2], a0[3], a1[0], a1[1], a1[2], a1[3]}, va1 = {b0[0], b0[1], b0[2], b0[3], b1[0], b1[1], b1[2], b1[3]};
                o0 = __builtin_amdgcn_mfma_f32_32x32x16_bf16(va0, pb[s_], o0, 0, 0, 0);
                o1 = __builtin_amdgcn_mfma_f32_32x32x16_bf16(va1, pb[s_], o1, 0, 0, 0);
            }
        }
        __syncthreads();
    }
    const float lt = lsum + __shfl_xor(lsum, 32), inv = 1.0f / lt;
    bf16* op = c.FEATS() + (size_t)qrow * C::D + 2 * C::BW + h * C::AH;
#pragma unroll
    for (int r4 = 0; r4 < 4; ++r4) {
        u32x2 w0, w1; w0.x = cvtpk(o0[4 * r4] * inv, o0[4 * r4 + 1] * inv); w0.y = cvtpk(o0[4 * r4 + 2] * inv, o0[4 * r4 + 3] * inv);
        w1.x = cvtpk(o1[4 * r4] * inv, o1[4 * r4 + 1] * inv); w1.y = cvtpk(o1[4 * r4 + 2] * inv, o1[4 * r4 + 3] * inv);
        *(u32x2*)(op + 8 * r4 + 4 * hi) = w0; *(u32x2*)(op + 32 + 8 * r4 + 4 * hi) = w1;
    }
}
__device__ __forceinline__ void attn_phase(const Ctx& c, int l, bool wc, LAS unsigned char* lds, int tid, int vcu, int G) {
    constexpr int NQB = C::S / 64, NXU = C::B * C::AKV * NQB, NCB = C::CT / 64, NCU = C::B * C::AKV * NCB;
    for (int u = vcu; u < NXU + (wc ? NCU : 0); u += G) {
        if (u < NXU) { const int qb = u % NQB, g = (u / NQB) % C::AKV, b = u / (NQB * C::AKV); attn_unit(c, l, lds, tid, b, g, b * C::S + qb * 64, qb * 64, false); }
        else { const int u2 = u - NXU; const int qb = u2 % NCB, g = (u2 / NCB) % C::AKV, b = u2 / (NCB * C::AKV); attn_unit(c, l, lds, tid, b, g, C::MX + b * C::CT + qb * 64, qb * 64, true); }
    }
}

constexpr int SC_STEPS = 32, SC_STEPB = PS_STEPF * 4, SC_BUFB = SC_STEPS * SC_STEPB;
template <int N> __device__ __forceinline__ float dpp_ror_add(float x) { const int y = __builtin_amdgcn_update_dpp(0, __builtin_bit_cast(int, x), 0x120 + N, 0xF, 0xF, false); return x + __builtin_bit_cast(float, y); }
__device__ __forceinline__ float row16_sum(float x) { x = dpp_ror_add<8>(x); x = dpp_ror_add<4>(x); x = dpp_ror_add<2>(x); x = dpp_ror_add<1>(x); return x; }
__device__ __forceinline__ int scan_row(int d, int b, int s) {
    if (s < C::CT) return C::MX + b * C::CT + (d == 0 ? s : C::CT - 1 - s);
    const int i = s - C::CT; return b * C::S + (d == 0 ? i : C::S - 1 - i);
}
struct ScanOps { f32x4 kk, w, kka, kr, r; float vv; };
__device__ __forceinline__ ScanOps scan_ld(const LAS unsigned char* p, int kg, int vr) {
    ScanOps o; o.kk = *(const LAS f32x4*)(p + kg * 16); o.w = *(const LAS f32x4*)(p + 256 + kg * 16); o.kka = *(const LAS f32x4*)(p + 512 + kg * 16);
    o.kr = *(const LAS f32x4*)(p + 768 + kg * 16); o.r = *(const LAS f32x4*)(p + 1024 + kg * 16); o.vv = *(const LAS float*)(p + 1280 + vr * 4); return o;
}
__device__ __forceinline__ void scan_phase(const Ctx& c, bool emit_ctx, LAS unsigned char* lds, int tid, int ucu, int UG) {
    const int lane = tid & 63, wave = __builtin_amdgcn_readfirstlane(tid >> 6);
    constexpr int NCHUNK = PS_NSTEP / SC_STEPS, NUNIT = 2 * C::B * C::RNH * 2, NPC = SC_BUFB / 1024 / NWAVES;
    for (int unit = ucu; unit < NUNIT; unit += UG) {
        const int hq = unit & 1, chain = unit >> 1, h = chain % C::RNH, b = (chain / C::RNH) % C::B, d = chain / (C::RNH * C::B);
        const float* src = c.PR() + ps_off(d, b, h, 0) + (size_t)wave * NPC * 256 + lane * 4;
#define SC_DMA(chunk, bufi) do { _Pragma("unroll") for (int q = 0; q < NPC; ++q) \
            __builtin_amdgcn_global_load_lds((const unsigned*)(src + (size_t)(chunk) * (SC_BUFB / 4) + q * 256), (LAS unsigned*)(lds + (bufi) * SC_BUFB + (wave * NPC + q) * 1024), 16, 0, 0); } while (0)
        const int kg = lane & 15, rloc = lane >> 4, vrow = 32 * hq + 4 * wave + rloc;
        float* yb = c.Y() + (size_t)d * C::MA * C::BW + h * C::RH + vrow;
        f32x4 S = {0.f, 0.f, 0.f, 0.f};
        SC_DMA(0, 0);
        asm volatile("s_waitcnt vmcnt(0)" ::: "memory"); __syncthreads();
        for (int k = 0; k < NCHUNK; ++k) {
            if (k + 1 < NCHUNK) SC_DMA(k + 1, (k + 1) & 1);
            const LAS unsigned char* bp = lds + (k & 1) * SC_BUFB;
            const bool emit = emit_ctx || k >= C::CT / SC_STEPS;
            const int row_k = scan_row(d, b, k * SC_STEPS), dt = d == 0 ? 1 : -1;
            ScanOps cur = scan_ld(bp, kg, vrow);
            float ykeep = 0.f;
#pragma unroll 2
            for (int s_ = 0; s_ < SC_STEPS; ++s_) {
                const ScanOps nx = scan_ld(bp + (s_ + 1 < SC_STEPS ? s_ + 1 : s_) * SC_STEPB, kg, vrow);
                float sa = -((S[0] * cur.kk[0] + S[1] * cur.kk[1]) + (S[2] * cur.kk[2] + S[3] * cur.kk[3]));
                sa = row16_sum(sa);
                S = S * cur.w + (sa * cur.kka + cur.vv * cur.kr);
                float y = (S[0] * cur.r[0] + S[1] * cur.r[1]) + (S[2] * cur.r[2] + S[3] * cur.r[3]);
                y = row16_sum(y);
                ykeep = (kg == (s_ & 15)) ? y : ykeep;
                if ((s_ & 15) == 15 && emit) yb[(size_t)(row_k + dt * ((s_ & ~15) + kg)) * C::BW] = ykeep;
                cur = nx;
            }
            asm volatile("s_waitcnt vmcnt(0)" ::: "memory"); __syncthreads();
        }
#undef SC_DMA
    }
}

template <int CTRL> __device__ __forceinline__ float dpp_add(float x) { const int y = __builtin_amdgcn_update_dpp(0, __builtin_bit_cast(int, x), CTRL, 0xF, 0xF, false); return x + __builtin_bit_cast(float, y); }
__device__ __forceinline__ float row8_sum(float x) { x = dpp_add<0xB1>(x); x = dpp_add<0x4E>(x); x = dpp_add<0x141>(x); return x; }
struct ScanOps8 { f32x4 kk0, kk1, w0, w1, ka0, ka1, kr0, kr1, r0, r1; float vv; };
__device__ __forceinline__ ScanOps8 scan_ld8(const LAS unsigned char* p, int kg, int vr) {
    ScanOps8 o; const LAS unsigned char* q = p + kg * 32;
    o.kk0 = *(const LAS f32x4*)(q); o.kk1 = *(const LAS f32x4*)(q + 16); o.w0 = *(const LAS f32x4*)(q + 256); o.w1 = *(const LAS f32x4*)(q + 272);
    o.ka0 = *(const LAS f32x4*)(q + 512); o.ka1 = *(const LAS f32x4*)(q + 528); o.kr0 = *(const LAS f32x4*)(q + 768); o.kr1 = *(const LAS f32x4*)(q + 784);
    o.r0 = *(const LAS f32x4*)(q + 1024); o.r1 = *(const LAS f32x4*)(q + 1040); o.vv = *(const LAS float*)(p + 1280 + vr * 4); return o;
}
__device__ __forceinline__ float hsum4(f32x4 a) { return (a[0] + a[1]) + (a[2] + a[3]); }
__device__ __forceinline__ void scan64_phase(const Ctx& c, bool emit_ctx, LAS unsigned char* lds, int tid, int ucu, int UG) {
    const int lane = tid & 63, wave = __builtin_amdgcn_readfirstlane(tid >> 6);
    constexpr int NCHUNK = PS_NSTEP / SC_STEPS, NUNIT = 2 * C::B * C::RNH, NPC = SC_BUFB / 1024 / NWAVES;
    for (int unit = ucu; unit < NUNIT; unit += UG) {
        const int chain = unit, h = chain % C::RNH, b = (chain / C::RNH) % C::B, d = chain / (C::RNH * C::B);
        const float* src = c.PR() + ps_off(d, b, h, 0) + (size_t)wave * NPC * 256 + lane * 4;
#define SC_FLUSH(kc) do { const int st_ = tid >> 4, part_ = tid & 15; const int rowf_ = scan_row(d, b, (kc) * SC_STEPS) + (d == 0 ? st_ : -st_); \
            *(f32x4*)(yg + (size_t)rowf_ * C::BW + part_ * 4) = *(const LAS f32x4*)(ybuf + (((kc) & 1) * SC_STEPS + st_) * C::RH + part_ * 4); } while (0)
#define SC_DMA(chunk, bufi) do { _Pragma("unroll") for (int q = 0; q < NPC; ++q) \
            __builtin_amdgcn_global_load_lds((const unsigned*)(src + (size_t)(chunk) * (SC_BUFB / 4) + q * 256), (LAS unsigned*)(lds + (bufi) * SC_BUFB + (wave * NPC + q) * 1024), 16, 0, 0); } while (0)
        const int kg = lane & 7, rloc = lane >> 3, vrow = 8 * wave + rloc;
        float* yg = c.Y() + (size_t)d * C::MA * C::BW + h * C::RH;
        LAS float* ybuf = (LAS float*)(lds + 2 * SC_BUFB);
        f32x4 S0 = {0.f, 0.f, 0.f, 0.f}, S1 = {0.f, 0.f, 0.f, 0.f};
        SC_DMA(0, 0);
        asm volatile("s_waitcnt vmcnt(0)" ::: "memory"); __syncthreads();
        for (int k = 0; k < NCHUNK; ++k) {
            if (k + 1 < NCHUNK) SC_DMA(k + 1, (k + 1) & 1);
            if (k > 0 && (emit_ctx || k - 1 >= C::CT / SC_STEPS)) SC_FLUSH(k - 1);
            const LAS unsigned char* bp = lds + (k & 1) * SC_BUFB;
            const bool emit = emit_ctx || k >= C::CT / SC_STEPS;
            const int row_k = scan_row(d, b, k * SC_STEPS), dt = d == 0 ? 1 : -1;
            const LAS unsigned char* pp = bp + kg * 32; const LAS unsigned char* pv = bp + 1280 + vrow * 4;
#define SC_LD8(o) do { o.kk0 = *(const LAS f32x4*)(pp); o.kk1 = *(const LAS f32x4*)(pp + 16); o.w0 = *(const LAS f32x4*)(pp + 256); o.w1 = *(const LAS f32x4*)(pp + 272); \
                o.ka0 = *(const LAS f32x4*)(pp + 512); o.ka1 = *(const LAS f32x4*)(pp + 528); o.kr0 = *(const LAS f32x4*)(pp + 768); o.kr1 = *(const LAS f32x4*)(pp + 784); \
                o.r0 = *(const LAS f32x4*)(pp + 1024); o.r1 = *(const LAS f32x4*)(pp + 1040); o.vv = *(const LAS float*)(pv); pp += SC_STEPB; pv += SC_STEPB; } while (0)
#define SC_STEP(o, s_) do { \
                float sa = -hsum4(S0 * o.kk0 + S1 * o.kk1); \
                sa = row8_sum(sa); \
                S0 = S0 * o.w0 + (sa * o.ka0 + o.vv * o.kr0); S1 = S1 * o.w1 + (sa * o.ka1 + o.vv * o.kr1); \
                float y = hsum4(S0 * o.r0 + S1 * o.r1); \
                y = row8_sum(y); \
                ykeep = (kg == ((s_) & 7)) ? y : ykeep; \
                if (((s_) & 7) == 7) ybuf[((k & 1) * SC_STEPS + ((s_) & ~7) + kg) * C::RH + vrow] = ykeep; } while (0)
            ScanOps8 ob3[3]; SC_LD8(ob3[0]); SC_LD8(ob3[1]);
            float ykeep = 0.f;
#pragma unroll
            for (int s_ = 0; s_ < SC_STEPS; ++s_) {
                if (s_ + 2 < SC_STEPS) SC_LD8(ob3[(s_ + 2) % 3]);
                SC_STEP(ob3[s_ % 3], s_);
            }
#undef SC_LD8
#undef SC_STEP
            asm volatile("s_waitcnt vmcnt(0)" ::: "memory"); __syncthreads();
        }
        SC_FLUSH(NCHUNK - 1);
        __syncthreads();
#undef SC_DMA
#undef SC_FLUSH
    }
}

constexpr int PM_FSTR = 272, PM_XSTR = 3 * C::BW * 2 + 16, PM_XOFF = 32 * PM_FSTR;
__device__ __forceinline__ float half32_sum(float x) { x = row16_sum(x); return x + __shfl_xor(x, 16); }
__device__ __forceinline__ void prep_mfma_phase(const Ctx& c, int l, LAS unsigned char* lds, int tid, int vcu, int G) {
    const int lane = tid & 63, h = __builtin_amdgcn_readfirstlane(tid >> 6), ql = lane & 31, hi = lane >> 5;
    constexpr int NCH = C::MA / 32;
    const int d = vcu & 1, dt = d == 0 ? 1 : -1;
    float* PS = c.PR();
    const float* mu = c.mu() + ((size_t)l * 2 + d) * C::SHW;
    bf16x8 wB[2][4], aB[2][4]; float w0[2], a0[2], kkw[2], kaw[2], mur[2], muk[2], muv[2], rkd[2];
#pragma unroll
    for (int ct = 0; ct < 2; ++ct) { const int ch = h * C::RH + 32 * ct + ql;
        w0[ct] = c.w0()[((size_t)l * 2 + d) * C::BW + ch]; a0[ct] = c.a0()[((size_t)l * 2 + d) * C::BW + ch]; kkw[ct] = c.k_k()[l * C::BW + ch]; kaw[ct] = c.k_a()[l * C::BW + ch];
        mur[ct] = mu[ch]; muk[ct] = mu[C::BW + ch]; muv[ct] = mu[2 * C::BW + ch]; rkd[ct] = c.r_k()[(((size_t)l * 2 + d) * C::RNH + h) * C::RH + 32 * ct + ql];
#pragma unroll
        for (int s_ = 0; s_ < 4; ++s_) { const float* wp = c.w_up() + (((size_t)l * 2 + d) * C::DL + 16 * s_ + 8 * hi) * C::BW + ch; const float* ap = c.a_up() + (((size_t)l * 2 + d) * C::AL + 16 * s_ + 8 * hi) * C::BW + ch;
            v4u ww, aa; ww.x = cvtpk(wp[0], wp[C::BW]); ww.y = cvtpk(wp[2 * C::BW], wp[3 * C::BW]); ww.z = cvtpk(wp[4 * C::BW], wp[5 * C::BW]); ww.w = cvtpk(wp[6 * C::BW], wp[7 * C::BW]);
            aa.x = cvtpk(ap[0], ap[C::BW]); aa.y = cvtpk(ap[2 * C::BW], ap[3 * C::BW]); aa.z = cvtpk(ap[4 * C::BW], ap[5 * C::BW]); aa.w = cvtpk(ap[6 * C::BW], ap[7 * C::BW]);
            wB[ct][s_] = __builtin_bit_cast(bf16x8, ww); aB[ct][s_] = __builtin_bit_cast(bf16x8, aa); } }
    for (int chunk = vcu >> 1; chunk < NCH; chunk += G >> 1) {
        const int row0 = chunk * 32; int b, t0, L, base; bool isc; row_info<C>(row0, b, t0, L, base, isc);
        const int tlo = d == 0 ? t0 - 1 : t0;
        { const int fi = tid & 127, lcol = C::O_LORA + d * C::DLW + fi; const float mu_l = mu[3 * C::BW + fi];
#pragma unroll
          for (int q = 0; q < 8; ++q) { const int i = (tid >> 7) + 4 * q, t = t0 + i, tp = t - dt;
              const float fl = bf2f(c.PX()[(size_t)(base + t) * C::PXW + lcol]); const float pl = (tp >= 0 && tp < L) ? bf2f(c.PX()[(size_t)(base + tp) * C::PXW + lcol]) : 0.f;
              const float m = fl + mu_l * (pl - fl); *(LAS bf16*)(lds + i * PM_FSTR + fi * 2) = f2bf(fi < C::DL ? ftanh(m) : m); } }
        for (int it = tid; it < 33 * (3 * C::BW / 8); it += NTHR) { const int ti = it / (3 * C::BW / 8), c8 = it - ti * (3 * C::BW / 8), t = tlo + ti;
            v4u val = {0u, 0u, 0u, 0u}; if (t >= 0 && t < L) val = *(const v4u*)(c.PX() + (size_t)(base + t) * C::PXW + c8 * 8);
            *(LAS v4u*)(lds + PM_XOFF + ti * PM_XSTR + c8 * 16) = val; }
        __syncthreads();
        f32x16 accW[2] = {}, accA[2] = {};
#pragma unroll
        for (int s_ = 0; s_ < 4; ++s_) { const bf16x8 fw = *(const LAS bf16x8*)(lds + ql * PM_FSTR + (16 * s_ + 8 * hi) * 2), fa = *(const LAS bf16x8*)(lds + ql * PM_FSTR + (C::DL + 16 * s_ + 8 * hi) * 2);
#pragma unroll
            for (int ct = 0; ct < 2; ++ct) { accW[ct] = __builtin_amdgcn_mfma_f32_32x32x16_bf16(fw, wB[ct][s_], accW[ct], 0, 0, 0); accA[ct] = __builtin_amdgcn_mfma_f32_32x32x16_bf16(fa, aB[ct][s_], accA[ct], 0, 0, 0); } }
#pragma unroll
        for (int r = 0; r < 16; ++r) { const int i = (r & 3) + 8 * (r >> 2) + 4 * hi, t = t0 + i, ti = t - tlo, tip = ti - dt;
            float kx[2], rx[2], vx[2], ss = 0.f;
#pragma unroll
            for (int ct = 0; ct < 2; ++ct) { const int cl = 32 * ct + ql, ch = h * C::RH + cl;
                const LAS bf16* pc = (const LAS bf16*)(lds + PM_XOFF + ti * PM_XSTR) + ch; const LAS bf16* pp = (const LAS bf16*)(lds + PM_XOFF + tip * PM_XSTR) + ch;
                const float fr_ = bf2f(pc[0]), fk_ = bf2f(pc[C::BW]), fv_ = bf2f(pc[2 * C::BW]), pr = bf2f(pp[0]), pk = bf2f(pp[C::BW]), pv = bf2f(pp[2 * C::BW]);
                rx[ct] = fr_ + mur[ct] * (pr - fr_); kx[ct] = fk_ + muk[ct] * (pk - fk_); vx[ct] = fv_ + muv[ct] * (pv - fv_);
                const float kv = kx[ct] * kkw[ct]; ss += kv * kv; }
            ss = half32_sum(ss); const float rn = __builtin_amdgcn_rcpf(fmaxf(sqrtf(ss), 1e-12f));
            float* ob = PS + ps_off(d, b, h, ps_step(d, isc, t)); float bsum = 0.f;
#pragma unroll
            for (int ct = 0; ct < 2; ++ct) { const int cl = 32 * ct + ql;
                const float wr = w0[ct] + accW[ct][r], ar = a0[ct] + accA[ct][r];
                const float z = -wr; const float sp = (z > 0.f ? z : 0.f) + flog(1.0f + fexp(-fabsf(z)));
                const float decay = fexp(-fexp(-sp - 0.5f)), a = fast_sigmoid(ar), kk = kx[ct] * kkw[ct] * rn, krep = kx[ct] * (1.0f + (a - 1.0f) * kaw[ct]);
                bsum += rx[ct] * krep * rkd[ct];
                float* o = ob + cl; o[0] = kk; o[C::RH] = decay; o[2 * C::RH] = kk * a; o[3 * C::RH] = krep; o[4 * C::RH] = rx[ct]; o[5 * C::RH] = vx[ct]; }
            bsum = half32_sum(bsum); if (ql == 0) c.BS()[((size_t)d * C::MA + base + t) * C::RNH + h] = bsum; }
        __syncthreads();
    }
}
__device__ __forceinline__ void readout_mfma_phase(const Ctx& c, int l, int nrows, LAS unsigned char* lds, int tid, int vcu, int G) {
    const int lane = tid & 63, h = __builtin_amdgcn_readfirstlane(tid >> 6), ql = lane & 31, hi = lane >> 5;
    const float* PS = c.PR();
    bf16x8 gB[2][8]; float lg[2], lbb[2], rk0[2], rk1[2];
#pragma unroll
    for (int ct = 0; ct < 2; ++ct) { const int cl = 32 * ct + ql, ch = h * C::RH + cl;
        lg[ct] = c.lnx_g()[l * C::BW + ch]; lbb[ct] = c.lnx_b()[l * C::BW + ch];
        rk0[ct] = c.r_k()[(((size_t)l * 2 + 0) * C::RNH + h) * C::RH + cl]; rk1[ct] = c.r_k()[(((size_t)l * 2 + 1) * C::RNH + h) * C::RH + cl];
#pragma unroll
        for (int s_ = 0; s_ < 8; ++s_) { const float* gp = c.g_up() + ((size_t)l * C::GL + 16 * s_ + 8 * hi) * C::BW + ch;
            v4u ww; ww.x = cvtpk(gp[0], gp[C::BW]); ww.y = cvtpk(gp[2 * C::BW], gp[3 * C::BW]); ww.z = cvtpk(gp[4 * C::BW], gp[5 * C::BW]); ww.w = cvtpk(gp[6 * C::BW], gp[7 * C::BW]);
            gB[ct][s_] = __builtin_bit_cast(bf16x8, ww); } }
    for (int unit = vcu; unit < nrows / 32; unit += G) {
        const int row0 = unit * 32; int b, t0, L, base; bool isc; row_info<C>(row0, b, t0, L, base, isc);
        { const int fi = tid & 127;
#pragma unroll
          for (int q = 0; q < 8; ++q) { const int i = (tid >> 7) + 4 * q;
              *(LAS bf16*)(lds + i * PM_FSTR + fi * 2) = f2bf(fast_sigmoid(bf2f(c.PX()[(size_t)(row0 + i) * C::PXW + C::O_G + fi]))); } }
        __syncthreads();
        f32x16 accG[2] = {};
#pragma unroll
        for (int s_ = 0; s_ < 8; ++s_) { const bf16x8 fa = *(const LAS bf16x8*)(lds + ql * PM_FSTR + (16 * s_ + 8 * hi) * 2);
#pragma unroll
            for (int ct = 0; ct < 2; ++ct) accG[ct] = __builtin_amdgcn_mfma_f32_32x32x16_bf16(fa, gB[ct][s_], accG[ct], 0, 0, 0); }
#pragma unroll
        for (int rg = 0; rg < 4; ++rg) {
            float ya[4][2], yb[4][2], va[4][2], vb[4][2], bs0[4], bs1[4];
#pragma unroll
            for (int rr = 0; rr < 4; ++rr) { const int i = rr + 8 * rg + 4 * hi, row = row0 + i, t = t0 + i;
                const float* p0 = PS + ps_off(0, b, h, ps_step(0, isc, t)); const float* p1 = PS + ps_off(1, b, h, ps_step(1, isc, t));
                const float* y0p = c.Y() + (size_t)row * C::BW + h * C::RH; const float* y1p = c.Y() + ((size_t)C::MA + row) * C::BW + h * C::RH;
                bs0[rr] = c.BS()[(size_t)row * C::RNH + h]; bs1[rr] = c.BS()[((size_t)C::MA + row) * C::RNH + h];
#pragma unroll
                for (int ct = 0; ct < 2; ++ct) { const int cl = 32 * ct + ql; ya[rr][ct] = y0p[cl]; yb[rr][ct] = y1p[cl]; va[rr][ct] = p0[5 * C::RH + cl]; vb[rr][ct] = p1[5 * C::RH + cl]; } }
#pragma unroll
            for (int rr = 0; rr < 4; ++rr) { const int r = 4 * rg + rr, i = rr + 8 * rg + 4 * hi, row = row0 + i;
                float y[2], sm = 0.f; const float s0 = bs0[rr], s1 = bs1[rr];
#pragma unroll
                for (int ct = 0; ct < 2; ++ct) { y[ct] = ya[rr][ct] + yb[rr][ct]; sm += y[ct]; }
                const float mean = half32_sum(sm) * (1.0f / C::RH);
                float sq = 0.f;
#pragma unroll
                for (int ct = 0; ct < 2; ++ct) { y[ct] -= mean; sq += y[ct] * y[ct]; }
                const float rs = __builtin_amdgcn_rsqf(half32_sum(sq) * (1.0f / C::RH) + 64e-5f);
#pragma unroll
                for (int ct = 0; ct < 2; ++ct) { const int cl = 32 * ct + ql;
                    const float yn = y[ct] * rs * lg[ct] + lbb[ct], bonus = s0 * va[rr][ct] + s1 * vb[rr][ct];
                    c.FEATS()[(size_t)row * C::D + C::BW + h * C::RH + cl] = f2bf((yn + bonus) * accG[ct][r]); } }
        }
        __syncthreads();
    }
}
__device__ __forceinline__ void el_tbd(bf16* T, long idx) {
    const int np = (int)(idx / C::BW), k = (int)(idx % C::BW), g = np / (2 * C::FGW), j = np % (2 * C::FGW), g2 = k / C::FGW, cc = k % C::FGW;
    float v = 0.f;
    if (g == g2) { const int jj = j % C::FGW; const float ang = 6.283185307179586f * (float)((jj * cc) % C::FGW) / (float)C::FGW; v = j < C::FGW ? cosf(ang) : -sinf(ang); }
    T[idx] = f2bf(v);
}
struct DEpiFnoA { bf16* YT; bf16* YTC;
    __device__ __forceinline__ bool operator()(f32x4 (&acc)[2][2][4][2], const pg8::Unit& u, int wr, int wc, int fr, int fq) const {
        EPI_LOOP({ int b, t, L, base; bool isc; row_info<C>(row, b, t, L, base, isc);
            const int g = col0 / (2 * C::FGW), j = col0 % (2 * C::FGW), im = j >= C::FGW ? 1 : 0, n = g * C::FGW + (j - im * C::FGW);
            bf16* dst = (isc ? YTC : YT) + ((size_t)b * C::BW + n) * 2 * L + im * L + t;
            dst[0] = f2bf(v[0]); dst[2 * L] = f2bf(v[1]); dst[4 * L] = f2bf(v[2]); dst[6 * L] = f2bf(v[3]); })
        return true;
    } };
__device__ __forceinline__ void el_ropetab(float* R, long idx) {
    constexpr int nf = C::AH / 4; const int t = (int)(idx / (C::AH / 2)), e = (int)(idx % (C::AH / 2)), half = e / nf, i = e % nf;
    const int pos = half == 0 ? t / C::GW : t % C::GW; const float inv = powf(10000.0f, -(float)i / (float)nf), ang = (float)pos * inv;
    R[2 * idx] = cosf(ang); R[2 * idx + 1] = sinf(ang);
}
__device__ __forceinline__ void el_rope_fast(const Ctx& c, long idx) {
    constexpr int PPR = (C::BW + C::AKVW) / 2, nf = C::AH / 4;
    const int row = (int)(idx / PPR), pp = (int)(idx % PPR); const bool isq = pp < C::BW / 2; const int p2 = isq ? pp : pp - C::BW / 2;
    const int hd = p2 / (C::AH / 2), e = p2 % (C::AH / 2), half = e / nf, i = e % nf, d1 = half * (C::AH / 2) + i, d2 = d1 + nf;
    const bf16* src = c.PX() + (size_t)row * C::PXW + (isq ? C::O_Q : C::O_KV) + hd * C::AH;
    bf16* dst = (isq ? c.QR() + (size_t)row * C::BW : c.KR() + (size_t)row * C::AKVW) + hd * C::AH;
    const float u1 = bf2f(src[d1]), u2 = bf2f(src[d2]);
    if (row >= C::MX) { dst[d1] = src[d1]; dst[d2] = src[d2]; return; }
    const int t = row % C::S; const float cs = c.ROPE()[((size_t)t * (C::AH / 2) + e) * 2], sn = c.ROPE()[((size_t)t * (C::AH / 2) + e) * 2 + 1];
    dst[d1] = f2bf(u1 * cs - u2 * sn); dst[d2] = f2bf(u2 * cs + u1 * sn);
}
constexpr int CV_T = 32;
__device__ __forceinline__ void conv_phase(const Ctx& c, int l, int nrows, LAS unsigned char* lds, int tid, int vcu, int G) {
    LAS float* cv = (LAS float*)lds;
    const int ch = tid, lane = tid & 63, wave = __builtin_amdgcn_readfirstlane(tid >> 6);
    constexpr int PAD = (C::CK - 1) / 2, NG = CV_T + C::CK - 1;
    float dw[C::CK];
#pragma unroll
    for (int j = 0; j < C::CK; ++j) dw[j] = c.conv_dw()[((size_t)l * C::CK + j) * C::BW + ch];
    const float bias = c.conv_dw_b()[l * C::BW + ch];
    for (int unit = vcu; unit < nrows / CV_T; unit += G) {
        const int row0 = unit * CV_T; int b, t0, L, base; bool isc; row_info<C>(row0, b, t0, L, base, isc);
        float gl[NG];
#pragma unroll
        for (int i = 0; i < NG; ++i) { const int tt = t0 + i - PAD; float v = 0.f;
            if (tt >= 0 && tt < L) { const bf16* p = c.PX() + (size_t)(base + tt) * C::PXW + C::O_CONV; v = bf2f(p[ch]) * fast_sigmoid(bf2f(p[C::BW + ch])); }
            gl[i] = v; }
#pragma unroll
        for (int i = 0; i < CV_T; ++i) { float s_ = bias;
#pragma unroll
            for (int j = 0; j < C::CK; ++j) s_ += gl[i + j] * dw[j];
            cv[i * C::BW + ch] = s_; }
        __syncthreads();
#pragma unroll
        for (int q = 0; q < CV_T / NWAVES; ++q) { const int i = wave * (CV_T / NWAVES) + q; float v[C::BW / 64]; float sm = 0.f;
#pragma unroll
            for (int e = 0; e < C::BW / 64; ++e) { v[e] = cv[i * C::BW + e * 64 + lane]; sm += v[e]; }
            const float mean = wave_sum(sm) * (1.0f / C::BW); float sq = 0.f;
#pragma unroll
            for (int e = 0; e < C::BW / 64; ++e) { v[e] -= mean; sq += v[e] * v[e]; }
            const float rs = 1.0f / sqrtf(wave_sum(sq) * (1.0f / C::BW) + 1e-5f);
#pragma unroll
            for (int e = 0; e < C::BW / 64; ++e) { const int k = e * 64 + lane; const float y = v[e] * rs * c.conv_ln_g()[l * C::BW + k] + c.conv_ln_b()[l * C::BW + k];
                c.FEATS()[(size_t)(row0 + i) * C::D + 3 * C::BW + k] = f2bf(y * fast_sigmoid(y)); } }
        __syncthreads();
    }
}
__device__ __forceinline__ void mod_partial_phase(const Ctx& c, LAS unsigned char* lds, int tid, int vcu, int G) {
    LAS float* sv = (LAS float*)lds;
    constexpr int NKC = C::D / 64, NCC = 6 * C::D / 2048, NU = C::DEPTH * NKC * NCC;
    static_assert(NKC == 32, "MODP holds 32 k chunks");
    for (int unit = vcu; unit < NU; unit += G) {
        const int cc = unit % NCC, kc = (unit / NCC) % NKC, l = unit / (NCC * NKC), k0 = kc * 64, col = cc * 2048 + tid * 4;
        if (tid < (C::B + 1) * 64) { const int r = tid / 64, k = tid % 64; const float x = r < C::B ? c.c()[r * C::D + k0 + k] : c.c_ctx()[k0 + k]; sv[tid] = x * sigmoidf_(x); }
        __syncthreads();
        f32x4 acc[C::B + 1];
#pragma unroll
        for (int r = 0; r <= C::B; ++r) acc[r] = (f32x4){0.f, 0.f, 0.f, 0.f};
        const float* wp = c.ada_w() + ((size_t)l * C::D + k0) * 6 * C::D + col;
#pragma unroll 8
        for (int k = 0; k < 64; ++k) { const f32x4 w = *(const f32x4*)(wp + (size_t)k * 6 * C::D);
#pragma unroll
            for (int r = 0; r <= C::B; ++r) acc[r] += sv[r * 64 + k] * w; }
#pragma unroll
        for (int r = 0; r <= C::B; ++r) *(f32x4*)(c.MODP() + (((size_t)kc * C::DEPTH + l) * (C::B + 1) + r) * 6 * C::D + col) = acc[r];
        __syncthreads();
    }
}
__device__ __forceinline__ void el_mod_reduce(const Ctx& c, long idx) {
    const int j = (int)(idx % (6 * C::D)); const int l = (int)(idx / ((long)(C::B + 1) * 6 * C::D));
    float s_ = c.ada_b()[l * 6 * C::D + j];
    for (int kc = 0; kc < 32; ++kc) s_ += c.MODP()[(size_t)kc * C::DEPTH * (C::B + 1) * 6 * C::D + idx];
    c.MOD()[idx] = s_;
}
__device__ __forceinline__ void hx_phase(const Ctx& c, int l, int which, int nrows, int lane, int gw, int NGW) {
    const float* gn = (which ? c.norm2_g() : c.norm1_g()) + l * C::D;
    for (int row = gw; row < nrows; row += NGW) {
        const float* xr = (l == 0 && which == 0) ? (row < C::MX ? c.x() + (size_t)row * C::D : c.ctx() + (size_t)(row - C::MX) * C::D) : c.X() + (size_t)row * C::D;
        const float* m = c.MOD() + ((size_t)l * (C::B + 1) + mod_row<C>(row)) * 6 * C::D;
        f32x4 v[C::D / 256]; float s_ = 0.f;
#pragma unroll
        for (int j = 0; j < C::D / 256; ++j) { v[j] = *(const f32x4*)(xr + (j * 64 + lane) * 4); s_ += (v[j][0] * v[j][0] + v[j][1] * v[j][1]) + (v[j][2] * v[j][2] + v[j][3] * v[j][3]); }
        const float rs = 1.0f / sqrtf(wave_sum(s_) * (1.0f / C::D) + 1e-6f);
#pragma unroll
        for (int j = 0; j < C::D / 256; ++j) { const int col = (j * 64 + lane) * 4; const f32x4 g = *(const f32x4*)(gn + col), sh = *(const f32x4*)(m + (which ? 3 : 0) * C::D + col), sc = *(const f32x4*)(m + (which ? 4 : 1) * C::D + col);
            const f32x4 y = v[j] * rs * g * (1.0f + sc) + sh; u32x2 w; w.x = cvtpk(y[0], y[1]); w.y = cvtpk(y[2], y[3]); *(u32x2*)(c.HX() + (size_t)row * C::D + col) = w; }
    }
}

__device__ __forceinline__ void convert_weights(const Ctx& c, int kind, int l, LAS float* scr, int lane, int wv, int nwv, int tid, long gt, long gts) {
    if (kind == 0) {
        constexpr int I_IN = (C::D / 64) * (C::IN_W / 64), I_B = (C::BW / 64) * (C::D / 64), I_O = (C::D / 64) * (C::D / 64);
        for (int it = wv; it < I_IN + 4 * I_B + I_O; it += nwv) {
            int r = it;
            if (r < I_IN) { transpose_item64(c.w_in() + (size_t)l * C::D * C::IN_W, C::D, C::IN_W, c.WinT(), scr, r, lane); continue; } r -= I_IN;
            if (r < 4 * I_B) { const int br = r / I_B; transpose_item64(c.w_branch() + ((size_t)l * 4 + br) * C::BW * C::D, C::BW, C::D, c.WbT() + (size_t)br * C::D * C::BW, scr, r % I_B, lane); continue; } r -= 4 * I_B;
            transpose_item64(c.w_out() + (size_t)l * C::D * C::D, C::D, C::D, c.WoT(), scr, r, lane);
        }
        for (long i = gt; i < (long)(C::PXW - C::IN_W) * C::D; i += gts) c.WinT()[(long)C::IN_W * C::D + i] = (bf16)0;
    } else {
        constexpr int I_1 = (C::D / 64) * (C::HID / 64), I_2 = (C::HID / 64) * (C::D / 64);
        for (int it = wv; it < I_1 + I_2; it += nwv) {
            if (it < I_1) transpose_item64(c.w_mlp1() + (size_t)l * C::D * C::HID, C::D, C::HID, c.W1T(), scr, it, lane);
            else transpose_item64(c.w_mlp2() + (size_t)l * C::HID * C::D, C::HID, C::D, c.W2T(), scr, it - I_1, lane);
        }
    }
    (void)tid;
}

struct Args { const float* in[30]; float* out; unsigned char* ws; };

__global__ void __launch_bounds__(NTHR, 2) mega_fwd(Args args) {
    extern __shared__ __attribute__((aligned(16))) unsigned char lds_raw[];
    LAS unsigned char* lds = (LAS unsigned char*)lds_raw;
    const int tid = threadIdx.x, lane = tid & 63, wave = __builtin_amdgcn_readfirstlane(tid >> 6);
    const int G = gridDim.x; const int bx = blockIdx.x; const int vcu = (G % 8 == 0) ? (bx % 8) * (G / 8) + bx / 8 : bx;
    const long gstride = (long)G * NTHR;
    const int gw = vcu * NWAVES + wave, NGW = G * NWAVES;
    typedef const CONSTAS Args* KArgs;
    KArgs ka = (KArgs)__builtin_amdgcn_kernarg_segment_ptr();
    unsigned char* ws = ka->ws;
#define PHASE_CTX() int tidp = threadIdx.x; asm volatile("" : "+v"(tidp)); const int lanep = tidp & 63; const long gtidp = (long)vcu * NTHR + tidp; Ctx c; { KArgs k_ = ka; asm volatile("" : "+s"(k_)); c.in = k_->in; c.out = k_->out; c.ws = k_->ws; }
    for (int u = tid; u < (LDS_BYTES - LDSCTL_OFF) / 4; u += NTHR) ((LAS unsigned*)(lds + LDSCTL_OFF))[u] = 0u;
    __syncthreads();
    volatile LAS unsigned* MISC = (volatile LAS unsigned*)(lds + MISC_OFF);
    XcdBarrier bar = xcd_barrier_post((unsigned*)(ws + WSMap::CTL) + CW_BAR, MISC + 8, (unsigned)G, true);
    const bool split = (G == 256); const bool is_scan = split && (vcu & 31) < 8;
    const int sidx = (vcu >> 5) * 8 + (vcu & 31), nidx = split ? (vcu >> 5) * 24 + (vcu & 31) - 8 : vcu, NG2 = split ? 192 : G;
    XcdBarrier bar2 = xcd_barrier_post((unsigned*)(ws + WSMap::CTL) + CW_BAR + XCD_BAR_WORDS, MISC + 10, 192u, split && !is_scan);
#define GRID_BAR() do { xcd_barrier(bar); if ((PROBE) == 99) xcd_barrier(bar); } while (0)
#define SUB_BAR() do { if (split) xcd_barrier(bar2); else xcd_barrier(bar); } while (0)
#define GSL(n, body) do { for (long i_ = gtidp; i_ < (long)(n); i_ += gstride) { body; } } while (0)
    LAS float* scr = (LAS float*)(lds + wave * 16384);

    RP(0) { PHASE_CTX();
#if EN_EL_DFT_TABLE
    GSL((long)C::S * 2 * C::S, el_dft_table<C>(c.TX(), C::S, i_));
#endif
#if EN_EL_DFT_TABLE
    GSL((long)C::CT * 2 * C::CT, el_dft_table<C>(c.TC(), C::CT, i_));
#endif
    GSL((long)2 * C::BW * C::BW, el_tbd(c.TBD(), i_));
    GSL((long)C::S * (C::AH / 2), el_ropetab(c.ROPE(), i_));
    mod_partial_phase(c, lds, tidp, vcu, G);
        }
    GRID_BAR();

    for (int l = 0; l < C::DEPTH; ++l) {
        const bool wc = l < C::DEPTH - 1; const int nrows = wc ? C::MA : C::MX; const int nMr = nrows / 256;
        if (l == 0) {
        RP(1) { PHASE_CTX();
            convert_weights(c, 0, 0, scr, lanep, gw, NGW, tidp, gtidp, gstride);
            GSL((long)C::DEPTH * (C::B + 1) * 6 * C::D, el_mod_reduce(c, i_));
        }
        GRID_BAR();
        }
        RP(2) { PHASE_CTX(); hx_phase(c, l, 0, C::MA, lanep, gw, NGW); }
        GRID_BAR();
        constexpr int NSTT = C::O_KV / 256;
        static_assert(C::O_KV % 256 == 0, "state columns end on a tile boundary");
        const int nsc = G >= 256 ? 64 : 0;
        RP(3) { PHASE_CTX();
            pg8::Gemm g{c.HX(), c.WinT(), C::D, C::D, C::D};
            pg8::RectSched S; S.G = G; S.c = vcu; S.nbr = 1; S.lda2 = (long)C::D * 2; S.ldb2 = (long)C::D * 2; S.abr = 0; S.bbr = 0;
            S.pm0_0 = 0; S.nM_0 = C::MX / 256; S.pn0_0 = 0; S.nN_0 = NSTT; S.blocked = true; S.bm = 4; S.bn = NSTT;
            S.pm0_1 = C::MX / 256; S.nM_1 = C::MC / 256; S.pn0_1 = 0; S.nN_1 = wc ? NSTT : C::CSC / 256;
            DEpiPX E{c.PX(), c.ROPE(), c.KR()};
            pg8::gemm_phase(lds, g, S, E, tidp);
        }
        GRID_BAR();
        { PHASE_CTX();
        RP(40) prep_mfma_phase(c, l, lds, tidp, vcu, G);
        }
        GRID_BAR();
        if (!split || is_scan) { PHASE_CTX();
            RP(50) scan64_phase(c, wc, lds, tidp, split ? sidx : vcu, split ? 64 : G);
        }
        if (!split) GRID_BAR();
        if (!split || !is_scan) {
            RP(31) { PHASE_CTX();
                pg8::Gemm g{c.HX(), c.WinT(), C::D, C::D, C::D};
                pg8::RectSched S; S.G = NG2; S.c = nidx; S.nbr = 1; S.lda2 = (long)C::D * 2; S.ldb2 = (long)C::D * 2; S.abr = 0; S.bbr = 0;
                S.pm0_0 = 0; S.nM_0 = C::MX / 256; S.pn0_0 = NSTT; S.nN_0 = C::PXW / 256 - NSTT; if (split && (C::PXW / 256 - NSTT) % 6 == 0) { S.blocked = true; S.bm = 4; S.bn = 6; }
                S.pm0_1 = C::MX / 256; S.nM_1 = C::MC / 256; S.pn0_1 = NSTT; S.nN_1 = wc ? C::PXW / 256 - NSTT : 0;
                DEpiPX E{c.PX(), c.ROPE(), c.KR()};
                pg8::gemm_phase(lds, g, S, E, tidp);
            }
            SUB_BAR();
            { PHASE_CTX();
            RP(42) conv_phase(c, l, nrows, lds, tidp, nidx, NG2);
            RP(43) {
                pg8::Gemm g{c.PX() + C::O_FNO, c.TBD(), C::PXW, C::BW, C::BW};
                pg8::RectSched S; S.G = NG2; S.c = nidx; S.nbr = 1; S.lda2 = (long)C::PXW * 2; S.ldb2 = (long)C::BW * 2; S.abr = 0; S.bbr = 0;
                S.pm0_0 = 0; int nMp = nMr; asm volatile("" : "+s"(nMp)); S.nM_0 = nMp; S.pn0_0 = 0; S.nN_0 = 2 * C::BW / 256; S.pm0_1 = 0; S.nM_1 = 0; S.pn0_1 = 0; S.nN_1 = 0;
                DEpiFnoA E{c.YT(), c.YTC()};
                pg8::gemm_phase(lds, g, S, E, tidp);
            }
            }
            SUB_BAR();
            RP(52) { PHASE_CTX();
                pg8::Gemm g{c.TX(), c.YT(), 2 * C::S, 2 * C::S, 2 * C::S};
                pg8::RectSched S; S.G = NG2; S.c = nidx; S.nbr = 1; S.lda2 = (long)2 * C::S * 2; S.ldb2 = (long)2 * C::S * 2; S.abr = 0; S.bbr = 0;
                S.pm0_0 = 0; S.nM_0 = C::S / 256; S.pn0_0 = 0; S.nN_0 = C::B * C::BW / 256; S.pm0_1 = 0; S.nM_1 = 0; S.pn0_1 = 0; S.nN_1 = 0;
                DEpiFno E{c.FEATS(), C::S, 0};
                pg8::gemm_phase(lds, g, S, E, tidp);
            }
            if (wc) { PHASE_CTX();
                pg8::Gemm g{c.TC(), c.YTC(), 2 * C::CT, 2 * C::CT, 2 * C::CT};
                pg8::RectSched S; S.G = NG2; S.c = (nidx + NG2 - 64) % NG2; S.nbr = 1; S.lda2 = (long)2 * C::CT * 2; S.ldb2 = (long)2 * C::CT * 2; S.abr = 0; S.bbr = 0;
                S.pm0_0 = 0; S.nM_0 = C::CT / 256; S.pn0_0 = 0; S.nN_0 = C::B * C::BW / 256; S.pm0_1 = 0; S.nM_1 = 0; S.pn0_1 = 0; S.nN_1 = 0;
                DEpiFno E{c.FEATS(), C::CT, C::MX};
                pg8::gemm_phase(lds, g, S, E, tidp);
            }
            { PHASE_CTX();
            const int na = NG2 > 144 ? NG2 - 72 : NG2;
            if (na == NG2 || nidx >= 72) RP(51) attn_phase(c, l, wc, lds, tidp, na == NG2 ? nidx : nidx - 72, na);
            }
        }
        GRID_BAR();
        RP(6) { PHASE_CTX(); readout_mfma_phase(c, l, nrows, lds, tidp, vcu, G); }
        GRID_BAR();
        RP(7) { PHASE_CTX();
            pg8::Gemm g{c.FEATS(), c.WbT(), C::D, C::BW, C::BW};
            pg8::RectSched S; S.G = G; S.c = vcu; S.nbr = 4; S.lda2 = (long)C::D * 2; S.ldb2 = (long)C::BW * 2; S.abr = (long)C::BW * 2; S.bbr = (long)C::D * C::BW * 2;
            S.pm0_0 = 0; int nMp = nMr; asm volatile("" : "+s"(nMp)); S.nM_0 = nMp; S.pn0_0 = 0; S.nN_0 = C::D / 256; S.pm0_1 = 0; S.nM_1 = 0; S.pn0_1 = 0; S.nN_1 = 0; S.blocked = true;
            DEpiMerge E{c.PX(), c.MIX()};
            pg8::gemm_phase(lds, g, S, E, tidp);
            { const int ntl = nMr * (C::D / 256), n2 = ntl > G ? ntl - G : 0;
              if (vcu >= n2) convert_weights(c, 1, l, scr, lanep, (vcu - n2) * NWAVES + wave, (G - n2) * NWAVES, tidp, 0, 1); }
        }
        GRID_BAR();
        { PHASE_CTX();
            const int ntl = nMr * (C::D / 256);
            if (ntl > G && (ntl * 8) % G == 0 && ntl * 8 / G >= 8) {
                pg8::Gemm g{c.MIX(), c.WoT(), C::D, C::D, C::D / 8};
                pg8::ChainSched S; S.G = G; S.c = vcu; int nMp = nMr; asm volatile("" : "+s"(nMp)); S.nM = nMp; S.ntl = ntl; S.nsl = 8; S.per = ntl * 8 / G; S.lda2 = (long)C::D * 2; S.ldb2 = (long)C::D * 2; S.ksl = (long)(C::D / 8) * 2;
                DEpiResChain E{c.X(), c.MOD() + (size_t)l * (C::B + 1) * 6 * C::D + 2 * C::D, (unsigned*)(c.ws + WSMap::CTL) + CW_FLAGS + (2 * l) * FLAG_BANK, nMp, l == 0 ? c.x() : nullptr, c.ctx()};
                pg8::gemm_phase(lds, g, S, E, tidp);
            } else {
            pg8::Gemm g{c.MIX(), c.WoT(), C::D, C::D, C::D};
            pg8::RectSched S; S.G = G; S.c = vcu; S.nbr = 1; S.lda2 = (long)C::D * 2; S.ldb2 = (long)C::D * 2; S.abr = 0; S.bbr = 0;
            S.pm0_0 = 0; int nMp = nMr; asm volatile("" : "+s"(nMp)); S.nM_0 = nMp; S.pn0_0 = 0; S.nN_0 = C::D / 256; S.pm0_1 = 0; S.nM_1 = 0; S.pn0_1 = 0; S.nN_1 = 0; S.blocked = true;
            DEpiRes E{c.X(), c.MOD() + (size_t)l * (C::B + 1) * 6 * C::D + 2 * C::D, l == 0 ? c.x() : nullptr, c.ctx()};
            pg8::gemm_phase(lds, g, S, E, tidp);
            }
        }
        GRID_BAR();
        RP(9) { PHASE_CTX();
            hx_phase(c, l, 1, nrows, lanep, gw, NGW);
        }
        GRID_BAR();
        RP(10) { PHASE_CTX();
            pg8::Gemm g{c.HX(), c.W1T(), C::D, C::D, C::D};
            pg8::RectSched S; S.G = G; S.c = vcu; S.nbr = 1; S.lda2 = (long)C::D * 2; S.ldb2 = (long)C::D * 2; S.abr = 0; S.bbr = 0;
            S.pm0_0 = 0; int nMp = nMr; asm volatile("" : "+s"(nMp)); S.nM_0 = nMp; S.pn0_0 = 0; S.nN_0 = C::HID / 256; S.pm0_1 = 0; S.nM_1 = 0; S.pn0_1 = 0; S.nN_1 = 0; S.blocked = true;
            DEpiMlp1 E{c.U()};
#if EN_GEMM && (GEMM_MASK & 32)
            pg8::gemm_phase(lds, g, S, E, tidp);
#endif
        }
        GRID_BAR();
        { PHASE_CTX();
            const int ntl = nMr * (C::D / 256), n2 = ntl > G ? ntl - G : 0;
            if (ntl > G && (ntl * 8) % G == 0 && ntl * 8 / G >= 8) {
                pg8::Gemm g{c.U(), c.W2T(), C::HID, C::HID, C::HID / 8};
                pg8::ChainSched S; S.G = G; S.c = vcu; int nMp = nMr; asm volatile("" : "+s"(nMp)); S.nM = nMp; S.ntl = ntl; S.nsl = 8; S.per = ntl * 8 / G; S.lda2 = (long)C::HID * 2; S.ldb2 = (long)C::HID * 2; S.ksl = (long)(C::HID / 8) * 2;
                DEpiResChain E{c.X(), c.MOD() + (size_t)l * (C::B + 1) * 6 * C::D + 5 * C::D, (unsigned*)(c.ws + WSMap::CTL) + CW_FLAGS + (2 * l + 1) * FLAG_BANK, nMp, nullptr, nullptr};
                pg8::gemm_phase(lds, g, S, E, tidp);
                if (l + 1 < C::DEPTH) convert_weights(c, 0, l + 1, scr, lanep, gw, NGW, tidp, gtidp, gstride);
            } else {
            pg8::Gemm g{c.U(), c.W2T(), C::HID, C::HID, C::HID};
            pg8::RectSched S; S.G = G; S.c = vcu; S.nbr = 1; S.lda2 = (long)C::HID * 2; S.ldb2 = (long)C::HID * 2; S.abr = 0; S.bbr = 0;
            S.pm0_0 = 0; int nMp = nMr; asm volatile("" : "+s"(nMp)); S.nM_0 = nMp; S.pn0_0 = 0; S.nN_0 = C::D / 256; S.pm0_1 = 0; S.nM_1 = 0; S.pn0_1 = 0; S.nN_1 = 0; S.blocked = true;
            DEpiRes E{c.X(), c.MOD() + (size_t)l * (C::B + 1) * 6 * C::D + 5 * C::D, nullptr, nullptr};
            pg8::gemm_phase(lds, g, S, E, tidp);
            if (l + 1 < C::DEPTH) { if (vcu >= n2) convert_weights(c, 0, l + 1, scr, lanep, (vcu - n2) * NWAVES + wave, (G - n2) * NWAVES, tidp, (long)(vcu - n2) * NTHR + tidp, (long)(G - n2) * NTHR); }
            }
        }
        GRID_BAR();
    }
    PHASE_CTX();
    for (int row = gw; row < C::MX; row += NGW) {
        const float* xr = c.X() + (size_t)row * C::D; float s = 0.f;
        for (int j = lanep; j < C::D; j += 64) s += xr[j] * xr[j];
        s = wave_sum(s); const float rs = 1.0f / sqrtf(s / (float)C::D + 1e-6f);
        for (int j = lanep; j < C::D; j += 64) c.out[(size_t)row * C::D + j] = xr[j] * rs * c.final_g()[j];
    }
}

extern "C" void kernel_launch(void* const* d_in, const int* in_sizes, int n_in, void* d_out, int out_size, void* d_ws, size_t ws_size, hipStream_t stream) {
    static int grid = 0;
    if (grid == 0) {
        if (n_in != 30 || out_size != C::MX * C::D || ws_size < WSMap::END) { fprintf(stderr, "kernel_launch: bad shapes: n_in %d out %d ws %zu (need %zu)\n", n_in, out_size, ws_size, (size_t)WSMap::END); grid = -1; return; }
        int dev = 0, cus = 0, per_cu = 0;
        if (hipGetDevice(&dev) != hipSuccess || hipDeviceGetAttribute(&cus, hipDeviceAttributeMultiprocessorCount, dev) != hipSuccess) { grid = -1; return; }
        if (hipFuncSetAttribute((const void*)mega_fwd, hipFuncAttributeMaxDynamicSharedMemorySize, LDS_BYTES) != hipSuccess) { fprintf(stderr, "kernel_launch: hipFuncSetAttribute failed\n"); grid = -1; return; }
        if (hipOccupancyMaxActiveBlocksPerMultiprocessor(&per_cu, (const void*)mega_fwd, NTHR, LDS_BYTES) != hipSuccess || per_cu < 1) { fprintf(stderr, "kernel_launch: occupancy query says %d\n", per_cu); grid = -1; return; }
        (void)hipGetLastError();
        grid = cus;
    }
    if (grid < 0) return;
    if (hipMemsetAsync((char*)d_ws + WSMap::CTL, 0, WSMap::CTL_BYTES, stream) != hipSuccess) return;
    Args a{};
    for (int i = 0; i < 30; ++i) a.in[i] = (const float*)d_in[i];
    a.out = (float*)d_out; a.ws = (unsigned char*)d_ws;
    hipLaunchKernelGGL(mega_fwd, dim3(grid), dim3(NTHR), LDS_BYTES, stream, a);
}
```

```cpp
#include <hip/hip_runtime.h>
#include <cstdio>
#include <cstdint>
#define HD __host__ __device__ __forceinline__
#define CONSTAS __attribute__((address_space(4)))
typedef unsigned short bf16;
HD float bf2f(bf16 h) { unsigned u = ((unsigned)h) << 16; float f; __builtin_memcpy(&f, &u, 4); return f; }
HD bf16 f2bf(float f) { unsigned u; __builtin_memcpy(&u, &f, 4); return (bf16)((u + 0x7fffu + ((u >> 16) & 1u)) >> 16); }
HD float sigmoidf_(float x) { return 1.0f / (1.0f + expf(-x)); }

template <int D_, int B_, int S_, int DEPTH_, int GW_, int CT_, int FG_, int RH_, int DL_, int AL_, int GL_, int AH_, int AKV_, int WIN_, int CK_>
struct CfgT {
    static constexpr int D = D_, B = B_, S = S_, DEPTH = DEPTH_, GW = GW_, CT = CT_;
    static constexpr int BW = D / 4, FG = FG_, FGW = BW / FG, RH = RH_, RNH = BW / RH, DL = DL_, AL = AL_, GL = GL_, DLW = DL + AL, SHW = 3 * BW + DLW;
    static constexpr int AH = AH_, ANH = BW / AH, AKV = AKV_, AREP = ANH / AKV, AKVW = AKV * AH, WIN = WIN_, CK = CK_, HID = 4 * D;
    static constexpr int O_LORA = 3 * BW, O_KV = O_LORA + 2 * DLW, CSC = O_KV + 2 * AKVW, O_G = CSC, O_Q = O_G + GL, O_FNO = O_Q + BW, O_CONV = O_FNO + BW,
                         O_GATE = O_CONV + 2 * BW, IN_W = O_GATE + 4 * D;
    static constexpr int PXW = (IN_W + 255) / 256 * 256;
    static constexpr int MX = B * S, MC = B * CT, MA = MX + MC;
};
typedef CfgT<2048, 4, 2048, 2, 64, 256, 4, 64, 64, 64, 128, 64, 2, 128, 31> CfgFull;
typedef CfgT<256, 2, 64, 2, 8, 16, 4, 16, 8, 8, 16, 16, 2, 8, 7> CfgSmall;

template <class C> struct WSMapT {
    static constexpr size_t al(size_t x) { return (x + 4095) / 4096 * 4096; }
};
constexpr size_t ws_al(size_t x) { return (x + 4095) / 4096 * 4096; }
template <class C> struct WSM {
    static constexpr size_t CTL = 0, CTL_BYTES = 1u << 20;
    static constexpr size_t MOD = CTL + CTL_BYTES;
    static constexpr size_t RSTD = MOD + ws_al((size_t)C::DEPTH * (C::B + 1) * 6 * C::D * 4);
    static constexpr size_t X = RSTD + ws_al((size_t)C::MA * 4);
    static constexpr size_t HX = X + ws_al((size_t)C::MA * C::D * 4);
    static constexpr size_t WREG = HX + ws_al((size_t)C::MA * C::D * 2);
    static constexpr size_t W2T = WREG, WoT = W2T + ws_al((size_t)C::D * C::HID * 2), WbT = WoT + ws_al((size_t)C::D * C::D * 2), U2 = WbT + ws_al((size_t)4 * C::D * C::BW * 2);
    static constexpr size_t WinT = U2, W1T = U2;
    static constexpr size_t WREG_END1 = WinT + ws_al((size_t)C::PXW * C::D * 2), WREG_END2 = W1T + ws_al((size_t)C::HID * C::D * 2);
    static constexpr size_t PX = WREG_END1 > WREG_END2 ? WREG_END1 : WREG_END2;
    static constexpr size_t PREP = PX + ws_al((size_t)C::MA * C::PXW * 2);
    static constexpr size_t PREP1 = ws_al((size_t)2 * C::MA * C::BW * 4);
    static constexpr size_t QR = PREP + 7 * PREP1;
    static constexpr size_t KR = QR + ws_al((size_t)C::MA * C::BW * 2);
    static constexpr size_t YT = KR + ws_al((size_t)C::MA * C::AKVW * 2);
    static constexpr size_t YTC = YT + ws_al((size_t)C::B * C::BW * 2 * C::S * 2);
    static constexpr size_t TX = YTC + ws_al((size_t)C::B * C::BW * 2 * C::CT * 2);
    static constexpr size_t TC = TX + ws_al((size_t)C::S * 2 * C::S * 2);
    static constexpr size_t FEATS = TC + ws_al((size_t)C::CT * 2 * C::CT * 2);
    static constexpr size_t TBD = FEATS + ws_al((size_t)C::MA * C::D * 2);
    static constexpr size_t ROPE = TBD + ws_al((size_t)2 * C::BW * C::BW * 2);
    static constexpr size_t MODP = ROPE + ws_al((size_t)C::S * (C::AH / 2) * 8);
    static constexpr size_t BS = MODP + ws_al((size_t)32 * C::DEPTH * (C::B + 1) * 6 * C::D * 4);
    static constexpr size_t END = BS + ws_al((size_t)2 * C::MA * C::RNH * 4);
    static_assert((size_t)C::MA * C::HID * 2 <= (size_t)C::MA * C::PXW * 2, "U overlays PX");
    static_assert((size_t)C::MA * C::D * 4 <= 7 * PREP1, "MSUM overlays PREP");
    static_assert((size_t)C::MA * C::BW * 4 <= (size_t)C::MA * C::D * 2, "CVB overlays HX");
};
template <class C> struct CtxT {
    const float* const CONSTAS* in; float* out; unsigned char* ws;
    typedef WSM<C> W;
    HD const float* x() const { return in[0]; }
    HD const float* c() const { return in[1]; }
    HD const float* ctx() const { return in[2]; }
    HD const float* c_ctx() const { return in[3]; }
    HD const float* ada_w() const { return in[4]; }
    HD const float* ada_b() const { return in[5]; }
    HD const float* norm1_g() const { return in[6]; }
    HD const float* norm2_g() const { return in[7]; }
    HD const float* w_in() const { return in[8]; }
    HD const float* mu() const { return in[9]; }
    HD const float* w0() const { return in[10]; }
    HD const float* w_up() const { return in[11]; }
    HD const float* a0() const { return in[12]; }
    HD const float* a_up() const { return in[13]; }
    HD const float* k_k() const { return in[14]; }
    HD const float* k_a() const { return in[15]; }
    HD const float* r_k() const { return in[16]; }
    HD const float* g_up() const { return in[17]; }
    HD const float* lnx_g() const { return in[18]; }
    HD const float* lnx_b() const { return in[19]; }
    HD const float* sink() const { return in[20]; }
    HD const float* conv_dw() const { return in[21]; }
    HD const float* conv_dw_b() const { return in[22]; }
    HD const float* conv_ln_g() const { return in[23]; }
    HD const float* conv_ln_b() const { return in[24]; }
    HD const float* w_branch() const { return in[25]; }
    HD const float* w_out() const { return in[26]; }
    HD const float* w_mlp1() const { return in[27]; }
    HD const float* w_mlp2() const { return in[28]; }
    HD const float* final_g() const { return in[29]; }
    HD float* MOD() const { return (float*)(ws + W::MOD); }
    HD float* X() const { return (float*)(ws + W::X); }
    HD float* RSTD() const { return (float*)(ws + W::RSTD); }
    HD bf16* HX() const { return (bf16*)(ws + W::HX); }
    HD bf16* MIX() const { return (bf16*)(ws + W::HX); }
    HD float* CVB() const { return (float*)(ws + W::HX); }
    HD bf16* WinT() const { return (bf16*)(ws + W::WinT); }
    HD bf16* WbT() const { return (bf16*)(ws + W::WbT); }
    HD bf16* WoT() const { return (bf16*)(ws + W::WoT); }
    HD bf16* W1T() const { return (bf16*)(ws + W::W1T); }
    HD bf16* W2T() const { return (bf16*)(ws + W::W2T); }
    HD bf16* PX() const { return (bf16*)(ws + W::PX); }
    HD bf16* U() const { return (bf16*)(ws + W::PX); }
    HD float* PR() const { return (float*)(ws + W::PREP); }
    HD float* PW() const { return (float*)(ws + W::PREP + W::PREP1); }
    HD float* PK() const { return (float*)(ws + W::PREP + 2 * W::PREP1); }
    HD float* PV() const { return (float*)(ws + W::PREP + 3 * W::PREP1); }
    HD float* PKK() const { return (float*)(ws + W::PREP + 4 * W::PREP1); }
    HD float* PA() const { return (float*)(ws + W::PREP + 5 * W::PREP1); }
    HD float* Y() const { return (float*)(ws + W::PREP + 6 * W::PREP1); }
    HD float* MSUM() const { return (float*)(ws + W::PREP); }
    HD bf16* QR() const { return (bf16*)(ws + W::QR); }
    HD bf16* KR() const { return (bf16*)(ws + W::KR); }
    HD bf16* YT() const { return (bf16*)(ws + W::YT); }
    HD bf16* YTC() const { return (bf16*)(ws + W::YTC); }
    HD bf16* TX() const { return (bf16*)(ws + W::TX); }
    HD bf16* TC() const { return (bf16*)(ws + W::TC); }
    HD bf16* FEATS() const { return (bf16*)(ws + W::FEATS); }
    HD bf16* TBD() const { return (bf16*)(ws + W::TBD); }
    HD float* ROPE() const { return (float*)(ws + W::ROPE); }
    HD float* MODP() const { return (float*)(ws + W::MODP); }
    HD float* BS() const { return (float*)(ws + W::BS); }
};

template <class C> HD void row_info(int row, int& b, int& t, int& L, int& base, bool& isctx) {
    if (row < C::MX) { b = row / C::S; t = row % C::S; L = C::S; base = b * C::S; isctx = false; }
    else { const int r = row - C::MX; b = r / C::CT; t = r % C::CT; L = C::CT; base = C::MX + b * C::CT; isctx = true; }
}
template <class C> HD int mod_row(int row) { return row < C::MX ? row / C::S : C::B; }

template <class C> HD void el_xcopy(const CtxT<C>& c, long idx) {
    c.X()[idx] = idx < (long)C::MX * C::D ? c.x()[idx] : c.ctx()[idx - (long)C::MX * C::D];
}
template <class C> HD void el_dft_table(bf16* T, int L, long idx) {
    const int t = (int)(idx / (2 * L)), k = (int)(idx % (2 * L));
    const int kk = k < L ? k : k - L; const int m = (int)(((long)t * kk) % L);
    const float ang = 6.283185307179586f * (float)m / (float)L;
    const float v = (k < L ? cosf(ang) : sinf(ang)) / sqrtf((float)L * (float)C::FGW);
    T[idx] = f2bf(v);
}
template <class C> HD void el_mod(const CtxT<C>& c, long idx) {
    const int l = (int)(idx / (6 * C::D)), j = (int)(idx % (6 * C::D));
    float acc[C::B + 1];
#pragma unroll
    for (int r = 0; r <= C::B; ++r) acc[r] = 0.f;
    for (int k = 0; k < C::D; ++k) {
        const float w = c.ada_w()[((long)l * C::D + k) * 6 * C::D + j];
#pragma unroll
        for (int r = 0; r <= C::B; ++r) { const float cv = r < C::B ? c.c()[r * C::D + k] : c.c_ctx()[k]; acc[r] += cv * sigmoidf_(cv) * w; }
    }
    const float bb = c.ada_b()[l * 6 * C::D + j];
#pragma unroll
    for (int r = 0; r <= C::B; ++r) c.MOD()[((long)l * (C::B + 1) + r) * 6 * C::D + j] = acc[r] + bb;
}
HD void el_wt(bf16* dst, const float* src, int K, int Nsrc, long idx) { const int n = (int)(idx / K), k = (int)(idx % K); dst[idx] = n < Nsrc ? f2bf(src[(long)k * Nsrc + n]) : (bf16)0; }

template <class C> HD void el_rstd(const CtxT<C>& c, int row) {
    float s = 0.f; const float* xr = c.X() + (long)row * C::D;
    for (int j = 0; j < C::D; ++j) s += xr[j] * xr[j];
    c.RSTD()[row] = 1.0f / sqrtf(s / (float)C::D + 1e-6f);
}
template <class C> HD void el_hx(const CtxT<C>& c, int l, int which, long idx) {
    const int row = (int)(idx / C::D), j = (int)(idx % C::D);
    const float* m = c.MOD() + ((long)l * (C::B + 1) + mod_row<C>(row)) * 6 * C::D;
    const float g = (which ? c.norm2_g() : c.norm1_g())[l * C::D + j];
    const float sh = m[(which ? 3 : 0) * C::D + j], sc = m[(which ? 4 : 1) * C::D + j];
    c.HX()[idx] = f2bf(c.X()[idx] * c.RSTD()[row] * g * (1.0f + sc) + sh);
}
template <class Epi> HD void el_gemm4(const bf16* A, int lda, const bf16* Bt, int ldb, int N, int K, const Epi& epi, long idx) {
    const int row = (int)(idx / (N / 4)), col0 = (int)(idx % (N / 4)) * 4;
    float v[4] = {0.f, 0.f, 0.f, 0.f};
    const bf16* a = A + (long)row * lda;
    for (int k = 0; k < K; ++k) { const float av = bf2f(a[k]);
#pragma unroll
        for (int q = 0; q < 4; ++q) v[q] += av * bf2f(Bt[(long)(col0 + q) * ldb + k]); }
    epi(row, col0, v);
}
template <class C> struct EpiPX { const CtxT<C>* c;
    HD void operator()(int row, int col0, const float* v) const {
#pragma unroll
        for (int q = 0; q < 4; ++q) { const int col = col0 + q; float y = v[q]; if (col >= C::O_GATE) y = sigmoidf_(y); c->PX()[(long)row * C::PXW + col] = f2bf(y); } } };
template <class C> struct EpiMerge { const CtxT<C>* c; int i;
    HD void operator()(int row, int col0, const float* v) const {
#pragma unroll
        for (int q = 0; q < 4; ++q) { const int col = col0 + q; float y = v[q] * bf2f(c->PX()[(long)row * C::PXW + C::O_GATE + i * C::D + col]);
            const long o = (long)row * C::D + col; if (i > 0) y += c->MSUM()[o]; if (i < 3) c->MSUM()[o] = y; else c->MIX()[o] = f2bf(y); } } };
template <class C> struct EpiRes { const CtxT<C>* c; int l, gidx;
    HD void operator()(int row, int col0, const float* v) const {
        const float* m = c->MOD() + ((long)l * (C::B + 1) + mod_row<C>(row)) * 6 * C::D + gidx * C::D;
#pragma unroll
        for (int q = 0; q < 4; ++q) { const long o = (long)row * C::D + col0 + q; c->X()[o] += m[col0 + q] * v[q]; } } };
template <class C> struct EpiMlp1 { const CtxT<C>* c;
    HD void operator()(int row, int col0, const float* v) const {
#pragma unroll
        for (int q = 0; q < 4; ++q) { const float r = v[q] > 0.f ? v[q] : 0.f; c->U()[(long)row * C::HID + col0 + q] = f2bf(r * r); } } };
template <class C> struct EpiFno { const CtxT<C>* c; int L, row0;
    HD void operator()(int t, int col0, const float* v) const {
#pragma unroll
        for (int q = 0; q < 4; ++q) { const int col = col0 + q, b = col / C::BW, n = col % C::BW; c->FEATS()[(long)(row0 + b * L + t) * C::D + n] = f2bf(v[q]); } } };

template <class C> HD float shiftfeat(const CtxT<C>& c, int l, int d, int row, int prow, int i) {
    const int col = i < 3 * C::BW ? i : C::O_LORA + d * C::DLW + (i - 3 * C::BW);
    const float f = bf2f(c.PX()[(long)row * C::PXW + col]);
    const float fp = prow >= 0 ? bf2f(c.PX()[(long)prow * C::PXW + col]) : 0.f;
    return f + c.mu()[((long)l * 2 + d) * C::SHW + i] * (fp - f);
}
template <class C> HD void el_prep(const CtxT<C>& c, int l, long idx) {
    const int ch = (int)(idx % C::BW); const long t2 = idx / C::BW; const int row = (int)(t2 % C::MA), d = (int)(t2 / C::MA);
    int b, t, L, base; bool isc; row_info<C>(row, b, t, L, base, isc);
    const int prow = d == 0 ? (t > 0 ? row - 1 : -1) : (t < L - 1 ? row + 1 : -1);
    const float r = shiftfeat<C>(c, l, d, row, prow, ch), k = shiftfeat<C>(c, l, d, row, prow, C::BW + ch), v = shiftfeat<C>(c, l, d, row, prow, 2 * C::BW + ch);
    float wr = c.w0()[((long)l * 2 + d) * C::BW + ch], ar = c.a0()[((long)l * 2 + d) * C::BW + ch];
    for (int j = 0; j < C::DL; ++j) wr += tanhf(shiftfeat<C>(c, l, d, row, prow, 3 * C::BW + j)) * c.w_up()[(((long)l * 2 + d) * C::DL + j) * C::BW + ch];
    for (int j = 0; j < C::AL; ++j) ar += shiftfeat<C>(c, l, d, row, prow, 3 * C::BW + C::DL + j) * c.a_up()[(((long)l * 2 + d) * C::AL + j) * C::BW + ch];
    const float z = -wr; const float sp = (z > 0.f ? z : 0.f) + log1pf(expf(-fabsf(z)));
    const float decay = expf(-expf(-sp - 0.5f));
    const float a = sigmoidf_(ar);
    const int h = ch / C::RH; float ss = 0.f;
    for (int c2 = h * C::RH; c2 < (h + 1) * C::RH; ++c2) { const float kv = shiftfeat<C>(c, l, d, row, prow, C::BW + c2) * c.k_k()[l * C::BW + c2]; ss += kv * kv; }
    const float nrm = sqrtf(ss); const float kk = k * c.k_k()[l * C::BW + ch] / (nrm > 1e-12f ? nrm : 1e-12f);
    const float krep = k * (1.0f + (a - 1.0f) * c.k_a()[l * C::BW + ch]);
    const long o = ((long)d * C::MA + row) * C::BW + ch;
    c.PR()[o] = r; c.PW()[o] = decay; c.PK()[o] = krep; c.PV()[o] = v; c.PKK()[o] = kk; c.PA()[o] = a;
}
template <class C> HD void el_scan(const CtxT<C>& c, bool emit_ctx, long idx) {
    const int vr = (int)(idx % C::RH); long t2 = idx / C::RH; const int h = (int)(t2 % C::RNH); t2 /= C::RNH; const int b = (int)(t2 % C::B), d = (int)(t2 / C::B);
    float S[C::RH];
#pragma unroll
    for (int k = 0; k < C::RH; ++k) S[k] = 0.f;
    for (int ph = 0; ph < 2; ++ph) {
        const int L = ph == 0 ? C::CT : C::S, base = ph == 0 ? C::MX + b * C::CT : b * C::S; const bool emit = ph == 1 || emit_ctx;
        for (int i = 0; i < L; ++i) {
            const int t = d == 0 ? i : L - 1 - i; const long off = ((long)d * C::MA + base + t) * C::BW + h * C::RH;
            float sa = 0.f;
#pragma unroll
            for (int k = 0; k < C::RH; ++k) sa -= S[k] * c.PKK()[off + k];
            const float vv = c.PV()[off + vr]; float y = 0.f;
#pragma unroll
            for (int k = 0; k < C::RH; ++k) { S[k] = S[k] * c.PW()[off + k] + sa * (c.PKK()[off + k] * c.PA()[off + k]) + vv * c.PK()[off + k]; y += S[k] * c.PR()[off + k]; }
            if (emit) c.Y()[off + vr] = y;
        }
    }
}
template <class C> HD void el_readout(const CtxT<C>& c, int l, long idx) {
    const int row = (int)(idx / C::BW), ch = (int)(idx % C::BW), h = ch / C::RH;
    const long o0 = (long)row * C::BW + h * C::RH, o1 = ((long)C::MA + row) * C::BW + h * C::RH;
    float mean = 0.f;
    for (int k = 0; k < C::RH; ++k) mean += c.Y()[o0 + k] + c.Y()[o1 + k];
    mean /= (float)C::RH; float var = 0.f;
    for (int k = 0; k < C::RH; ++k) { const float dv = c.Y()[o0 + k] + c.Y()[o1 + k] - mean; var += dv * dv; }
    var /= (float)C::RH;
    const float y = c.Y()[o0 + ch - h * C::RH] + c.Y()[o1 + ch - h * C::RH];
    const float yn = (y - mean) / sqrtf(var + 64e-5f) * c.lnx_g()[l * C::BW + ch] + c.lnx_b()[l * C::BW + ch];
    float bonus = 0.f;
    for (int d = 0; d < 2; ++d) { const long od = d == 0 ? o0 : o1; float s = 0.f;
        for (int k = 0; k < C::RH; ++k) s += c.PR()[od + k] * c.PK()[od + k] * c.r_k()[(((long)l * 2 + d) * C::RNH + h) * C::RH + k];
        bonus += s * c.PV()[od + ch - h * C::RH]; }
    float g = 0.f;
    for (int j = 0; j < C::GL; ++j) g += sigmoidf_(bf2f(c.PX()[(long)row * C::PXW + C::O_G + j])) * c.g_up()[((long)l * C::GL + j) * C::BW + ch];
    c.FEATS()[(long)row * C::D + 1 * C::BW + ch] = f2bf((yn + bonus) * g);
}
template <class C> HD float rope_el(const bf16* src, int dd, int t, bool rot) {
    const float u = bf2f(src[dd]); if (!rot) return u;
    constexpr int hs = C::AH / 2, nf = hs / 2;
    const int half = dd / hs, dp = dd % hs, i = dp % nf; const bool first = dp < nf;
    const int pos = half == 0 ? t / C::GW : t % C::GW;
    const float inv = powf(10000.0f, -(float)i / (float)nf), ang = (float)pos * inv, cs = cosf(ang), sn = sinf(ang);
    const float p = bf2f(src[first ? dd + nf : dd - nf]);
    return first ? u * cs - p * sn : u * cs + p * sn;
}
template <class C> HD void el_rope(const CtxT<C>& c, long idx) {
    const int row = (int)(idx / (C::BW + C::AKVW)), j = (int)(idx % (C::BW + C::AKVW));
    int b, t, L, base; bool isc; row_info<C>(row, b, t, L, base, isc);
    if (j < C::BW) { const int h = j / C::AH, dd = j % C::AH; c.QR()[(long)row * C::BW + j] = f2bf(rope_el<C>(c.PX() + (long)row * C::PXW + C::O_Q + h * C::AH, dd, t, !isc)); }
    else { const int j2 = j - C::BW, g = j2 / C::AH, dd = j2 % C::AH; c.KR()[(long)row * C::AKVW + j2] = f2bf(rope_el<C>(c.PX() + (long)row * C::PXW + C::O_KV + g * C::AH, dd, t, !isc)); }
}
template <class C> HD void el_attn(const CtxT<C>& c, int l, long idx) {
    const int row = (int)(idx / C::ANH), h = (int)(idx % C::ANH), g = h / C::AREP;
    int b, t, L, base; bool isc; row_info<C>(row, b, t, L, base, isc);
    float q[C::AH], acc[C::AH];
#pragma unroll
    for (int dd = 0; dd < C::AH; ++dd) { q[dd] = bf2f(c.QR()[(long)row * C::BW + h * C::AH + dd]); acc[dd] = 0.f; }
    const float scale = 1.0f / sqrtf((float)C::AH);
    float m = c.sink()[l * C::ANH + h], den = 1.0f;
    const int nloc = isc ? 0 : 2 * C::WIN + 1;
    for (int jj = 0; jj < nloc + C::CT; ++jj) {
        int krow;
        if (jj < nloc) { const int j = t - C::WIN + jj; if (j < 0 || j >= L) continue; krow = base + j; }
        else krow = C::MX + b * C::CT + (jj - nloc);
        const bf16* kp = c.KR() + (long)krow * C::AKVW + g * C::AH; float s = 0.f;
#pragma unroll
        for (int dd = 0; dd < C::AH; ++dd) s += q[dd] * bf2f(kp[dd]);
        s *= scale;
        const float mn = s > m ? s : m, f = expf(m - mn), p = expf(s - mn);
        const bf16* vp = c.PX() + (long)krow * C::PXW + C::O_KV + C::AKVW + g * C::AH;
        den = den * f + p;
#pragma unroll
        for (int dd = 0; dd < C::AH; ++dd) acc[dd] = acc[dd] * f + p * bf2f(vp[dd]);
        m = mn;
    }
#pragma unroll
    for (int dd = 0; dd < C::AH; ++dd) c.FEATS()[(long)row * C::D + 2 * C::BW + h * C::AH + dd] = f2bf(acc[dd] / den);
}
template <class C> HD void el_fnoA(const CtxT<C>& c, long idx) {
    const int row = (int)(idx / C::BW), n = (int)(idx % C::BW), g = n / C::FGW, cf = n % C::FGW;
    int b, t, L, base; bool isc; row_info<C>(row, b, t, L, base, isc);
    float ar = 0.f, ai = 0.f;
    for (int cp = 0; cp < C::FGW; ++cp) { const float u = bf2f(c.PX()[(long)row * C::PXW + C::O_FNO + g * C::FGW + cp]);
        const float ang = 6.283185307179586f * (float)((cf * cp) % C::FGW) / (float)C::FGW; ar += u * cosf(ang); ai -= u * sinf(ang); }
    bf16* yt = (isc ? c.YTC() : c.YT()) + ((long)b * C::BW + n) * 2 * L;
    yt[t] = f2bf(ar); yt[L + t] = f2bf(ai);
}
template <class C> HD void el_conv(const CtxT<C>& c, int l, long idx) {
    const int row = (int)(idx / C::BW), ch = (int)(idx % C::BW);
    int b, t, L, base; bool isc; row_info<C>(row, b, t, L, base, isc);
    float s = c.conv_dw_b()[l * C::BW + ch];
    for (int j = 0; j < C::CK; ++j) { const int tt = t + j - (C::CK - 1) / 2; if (tt < 0 || tt >= L) continue;
        const bf16* p = c.PX() + (long)(base + tt) * C::PXW + C::O_CONV;
        s += bf2f(p[ch]) * sigmoidf_(bf2f(p[C::BW + ch])) * c.conv_dw()[((long)l * C::CK + j) * C::BW + ch]; }
    c.CVB()[idx] = s;
}
template <class C> HD void el_convln(const CtxT<C>& c, int l, int row) {
    const float* v = c.CVB() + (long)row * C::BW; float mean = 0.f;
    for (int k = 0; k < C::BW; ++k) mean += v[k];
    mean /= (float)C::BW; float var = 0.f;
    for (int k = 0; k < C::BW; ++k) { const float dv = v[k] - mean; var += dv * dv; }
    var /= (float)C::BW; const float rs = 1.0f / sqrtf(var + 1e-5f);
    for (int k = 0; k < C::BW; ++k) { const float y = (v[k] - mean) * rs * c.conv_ln_g()[l * C::BW + k] + c.conv_ln_b()[l * C::BW + k]; c.FEATS()[(long)row * C::D + 3 * C::BW + k] = f2bf(y * sigmoidf_(y)); }
}
template <class C> HD void el_final(const CtxT<C>& c, int row) {
    float s = 0.f; const float* xr = c.X() + (long)row * C::D;
    for (int j = 0; j < C::D; ++j) s += xr[j] * xr[j];
    const float rs = 1.0f / sqrtf(s / (float)C::D + 1e-6f);
    for (int j = 0; j < C::D; ++j) c.out[(long)row * C::D + j] = xr[j] * rs * c.final_g()[j];
}
typedef CfgFull C;
#ifndef PROBE
#define PROBE -1
#endif
#define RP(k) for (int rp_ = 0; rp_ < ((PROBE) == (k) ? 2 : 1); ++rp_)
#ifndef GEMM_MASK
#define GEMM_MASK 0xFF
#endif
#ifndef EN_ALL
#define EN_ALL 1
#endif
#ifndef EN_GEMM
#define EN_GEMM EN_ALL
#endif
#ifndef EN_EL_XCOPY
#define EN_EL_XCOPY EN_ALL
#endif
#ifndef EN_EL_DFT_TABLE
#define EN_EL_DFT_TABLE EN_ALL
#endif
#ifndef EN_EL_MOD
#define EN_EL_MOD EN_ALL
#endif
#ifndef EN_MISC
#define EN_MISC EN_ALL
#endif
#ifndef EN_EL_HX
#define EN_EL_HX EN_ALL
#endif
#ifndef EN_EL_PREP
#define EN_EL_PREP EN_ALL
#endif
#ifndef EN_EL_ROPE
#define EN_EL_ROPE EN_ALL
#endif
#ifndef EN_EL_FNOA
#define EN_EL_FNOA EN_ALL
#endif
#ifndef EN_EL_CONV
#define EN_EL_CONV EN_ALL
#endif
#ifndef EN_EL_SCAN
#define EN_EL_SCAN EN_ALL
#endif
#ifndef EN_EL_ATTN
#define EN_EL_ATTN EN_ALL
#endif
#ifndef EN_EL_CONVLN
#define EN_EL_CONVLN EN_ALL
#endif
#ifndef EN_EL_READOUT
#define EN_EL_READOUT EN_ALL
#endif
#define GAS __attribute__((address_space(1)))
#define LAS __attribute__((address_space(3)))
typedef unsigned v4u __attribute__((ext_vector_type(4)));
typedef float f32x4 __attribute__((ext_vector_type(4)));
typedef short bf16x8 __attribute__((ext_vector_type(8)));
typedef GAS unsigned gu32;
#define RLX_AGENT __ATOMIC_RELAXED, __HIP_MEMORY_SCOPE_AGENT
#define LDS_WAIT() asm volatile("s_waitcnt lgkmcnt(0)" ::: "memory")

typedef WSM<C> WSMap;
typedef CtxT<C> Ctx;

namespace pg8 {
constexpr int BM = 256, BK = 64, HALF = 128, HTB = HALF * BK * 2, STAGE_BYTES = 8 * HTB;
__host__ __device__ __forceinline__ int lds_byte(int r, int c) { const int st = (r >> 4) * 2 + (c >> 5), rr = r & 15, cc = c & 31, ob = rr * 64 + cc * 2; return st * 1024 + (ob ^ (((ob >> 9) & 1) << 5)); }
__host__ __device__ __forceinline__ void stage_rc(int b, int& R, int& Cc) { const int st = b / 1024, sb = b % 1024, swz = sb ^ (((sb >> 9) & 1) << 5); R = (st >> 1) * 16 + swz / 64; Cc = (st & 1) * 32 + (swz % 64) / 2; }
__host__ __device__ __forceinline__ int perm32(int rho) { const int n = rho >> 4, i = rho & 15; return 8 * (i >> 2) + 4 * n + (i & 3); }
struct Unit { int pm, pn, tag; long aoff, boff; };
struct Gemm { const bf16* A; const bf16* Bt; int lda, ldb, K; };

template <class Epi, class Sched>
__device__ __forceinline__ void gemm_phase(LAS unsigned char* lds, const Gemm g, const Sched& S, const Epi& E, const int tid) {
    const int wid = __builtin_amdgcn_readfirstlane(tid >> 6), lane = tid & 63, wr = wid >> 2, wc = wid & 3, fr = lane & 15, fq = lane >> 4;
    const int K = g.K, nt = K / BK;
    unsigned voffA[2], voffB[2];
#pragma unroll
    for (int i = 0; i < 2; ++i) { int R, Cc; stage_rc(tid * 16 + i * 8192, R, Cc); const int Rb = (R & ~31) + perm32(R & 31); voffA[i] = (unsigned)(R * g.lda + Cc) * 2u; voffB[i] = (unsigned)(Rb * g.ldb + Cc) * 2u; }
    const size_t kstep = (size_t)(BK * 2);
    const size_t hstepA = (size_t)HALF * g.lda * 2, hstepB = (size_t)HALF * g.ldb * 2;
    const unsigned ldsw = (unsigned)wid * 1024u;
    const int aoff = lds_byte(wr * 64 + fr, fq * 8), boff = lds_byte(wc * 32 + fr, fq * 8);
#define PG8_SA(b, h) (((b) * 2 + (h)) * HTB)
#define PG8_SB(b, h) ((4 + (b) * 2 + (h)) * HTB)
#define PG8_STAGE(bufoff, gbase, voff) do { _Pragma("unroll") for (int _i = 0; _i < 2; ++_i) \
        __builtin_amdgcn_global_load_lds((const unsigned*)((const char*)(gbase) + (voff)[_i]), (LAS unsigned*)(lds + (bufoff) + ldsw + _i * 8192), 16, 0, 0); } while (0)
#define PG8_LDA(dst, b, h) do { _Pragma("unroll") for (int m = 0; m < 4; ++m) _Pragma("unroll") for (int k = 0; k < 2; ++k) dst[m][k] = *(const LAS bf16x8*)(lds + PG8_SA(b, h) + aoff + m * 2048 + k * 1024); } while (0)
#define PG8_LDB(dst, b, h) do { _Pragma("unroll") for (int n = 0; n < 2; ++n) _Pragma("unroll") for (int k = 0; k < 2; ++k) dst[n][k] = *(const LAS bf16x8*)(lds + PG8_SB(b, h) + boff + n * 2048 + k * 1024); } while (0)
#define PG8_MMA(ai, bj, At, Bt) do { __builtin_amdgcn_s_setprio(1); _Pragma("unroll") for (int m = 0; m < 4; ++m) _Pragma("unroll") for (int n = 0; n < 2; ++n) _Pragma("unroll") for (int k = 0; k < 2; ++k) \
        acc[ai][bj][m][n] = __builtin_amdgcn_mfma_f32_16x16x32_bf16(Bt[n][k], At[m][k], acc[ai][bj][m][n], 0, 0, 0); __builtin_amdgcn_s_setprio(0); } while (0)
#define PG8_WAIT_V(n) asm volatile("s_waitcnt vmcnt(" #n ")" ::: "memory")
#define PG8_WAIT_L(n) asm volatile("s_waitcnt lgkmcnt(" #n ")" ::: "memory")
#define PG8_BAR __builtin_amdgcn_s_barrier()
#define PG8_SCHED __builtin_amdgcn_sched_barrier(0)
    Unit cur, nxt; int ui = 0;
    if (!S.next(0, cur)) return;
    f32x4 acc[2][2][4][2];
#pragma unroll
    for (int a = 0; a < 2; ++a)
#pragma unroll
        for (int b = 0; b < 2; ++b)
#pragma unroll
            for (int m = 0; m < 4; ++m)
#pragma unroll
                for (int n = 0; n < 2; ++n) acc[a][b][m][n] = (f32x4){0.f, 0.f, 0.f, 0.f};
    bf16x8 At[4][2], B0[2][2], B1[2][2];
    const char* cA = (const char*)g.A + cur.aoff; const char* cB = (const char*)g.Bt + cur.boff;
    PG8_STAGE(PG8_SB(0, 0), cB, voffB); PG8_STAGE(PG8_SB(0, 1), cB + hstepB, voffB); PG8_STAGE(PG8_SA(0, 0), cA, voffA); PG8_STAGE(PG8_SA(0, 1), cA + hstepA, voffA);
    if (wr == 1) PG8_BAR;
    PG8_WAIT_V(2); PG8_BAR;
    PG8_STAGE(PG8_SB(1, 0), cB + kstep, voffB); PG8_STAGE(PG8_SA(1, 0), cA + kstep, voffA); PG8_STAGE(PG8_SB(1, 1), cB + hstepB + kstep, voffB);
    PG8_WAIT_V(6); PG8_BAR;
    for (;;) {
        const bool has_next = S.next(ui + 1, nxt);
        const char* nA = has_next ? (const char*)g.A + nxt.aoff : cA; const char* nB = has_next ? (const char*)g.Bt + nxt.boff : cB;
        for (int t = 0; t < nt; t += 2) {
            const bool last = (t == nt - 2);
            const char* a1 = cA + (size_t)(t + 1) * kstep;
            const char* a2 = last ? nA : cA + (size_t)(t + 2) * kstep; const char* b2 = last ? nB : cB + (size_t)(t + 2) * kstep;
            const char* a3 = a2 + kstep; const char* b3 = b2 + kstep;
            PG8_LDB(B0, 0, 0); PG8_LDB(B1, 0, 1); PG8_SCHED; PG8_LDA(At, 0, 0); PG8_STAGE(PG8_SA(1, 1), a1 + hstepA, voffA);
            PG8_WAIT_V(8); PG8_WAIT_L(0); PG8_BAR; PG8_MMA(0, 0, At, B0); PG8_MMA(0, 1, At, B1); PG8_BAR; PG8_SCHED;
            PG8_LDA(At, 0, 1); PG8_STAGE(PG8_SB(0, 0), b2, voffB); PG8_STAGE(PG8_SB(0, 1), b2 + hstepB, voffB); PG8_STAGE(PG8_SA(0, 0), a2, voffA);
            PG8_WAIT_V(8); PG8_WAIT_L(0); PG8_BAR; PG8_MMA(1, 0, At, B0); PG8_MMA(1, 1, At, B1); PG8_BAR; PG8_SCHED;
            PG8_LDB(B0, 1, 0); PG8_LDB(B1, 1, 1); PG8_SCHED; PG8_LDA(At, 1, 0); PG8_STAGE(PG8_SA(0, 1), a2 + hstepA, voffA);
            PG8_WAIT_V(8); PG8_WAIT_L(0); PG8_BAR; PG8_MMA(0, 0, At, B0); PG8_MMA(0, 1, At, B1); PG8_BAR; PG8_SCHED;
            PG8_LDA(At, 1, 1); PG8_STAGE(PG8_SB(1, 0), b3, voffB); PG8_STAGE(PG8_SB(1, 1), b3 + hstepB, voffB); PG8_STAGE(PG8_SA(1, 0), a3, voffA);
            PG8_WAIT_V(8); PG8_WAIT_L(0); PG8_BAR; PG8_MMA(1, 0, At, B0); PG8_MMA(1, 1, At, B1); PG8_BAR; PG8_SCHED;
        }
        if (wr == 0) PG8_BAR;
        const bool zero_acc = E(acc, cur, wr, wc, fr, fq);
        if (!has_next) break;
        if (zero_acc)
#pragma unroll
        for (int a = 0; a < 2; ++a)
#pragma unroll
            for (int b = 0; b < 2; ++b)
#pragma unroll
                for (int m = 0; m < 4; ++m)
#pragma unroll
                    for (int n = 0; n < 2; ++n) acc[a][b][m][n] = (f32x4){0.f, 0.f, 0.f, 0.f};
        cur = nxt; cA = nA; cB = nB; ++ui;
        if (wr == 1) PG8_BAR;
    }
    PG8_WAIT_V(0);
    PG8_BAR;
#undef PG8_SA
#undef PG8_SB
#undef PG8_STAGE
#undef PG8_LDA
#undef PG8_LDB
#undef PG8_MMA
#undef PG8_WAIT_V
#undef PG8_WAIT_L
#undef PG8_BAR
#undef PG8_SCHED
}
template <class E4> struct EpiWrap { E4 e;
    __device__ __forceinline__ void operator()(const f32x4 (&acc)[2][2][4][2], const Unit& u, int wr, int wc, int fr, int fq) const {
#pragma unroll
        for (int ai = 0; ai < 2; ++ai)
#pragma unroll
            for (int m = 0; m < 4; ++m)
#pragma unroll
                for (int bj = 0; bj < 2; ++bj)
#pragma unroll
                    for (int n = 0; n < 2; ++n) { const int row = u.pm * 256 + ai * 128 + wr * 64 + m * 16 + fr, col0 = u.pn * 256 + bj * 128 + wc * 32 + fq * 8 + n * 4;
                        const f32x4 a = acc[ai][bj][m][n]; const float v[4] = {a[0], a[1], a[2], a[3]}; e(u, row, col0, v); }
    }
};
struct RectSched {
    int G, c, nbr; int pm0_0, nM_0, pn0_0, nN_0, pm0_1, nM_1, pn0_1, nN_1; long lda2, ldb2, abr, bbr;
    bool blocked = false; int bm = 4, bn = 8;
    __device__ __forceinline__ bool next(int i, Unit& u) const {
        const int round = (nbr == 1) ? i : (i >> 2), br = (nbr == 1) ? 0 : (i & 3); int L = round * G + c;
        const int n0 = nM_0 * nN_0, n1 = nM_1 * nN_1;
        bool r = false; if (L >= n0) { L -= n0; r = true; if (L >= n1) return false; }
        const unsigned nm = (unsigned)(r ? nM_1 : nM_0); unsigned q = (unsigned)L / nm, rem = (unsigned)L - q * nm;
        const unsigned nn_ = (unsigned)nN_0; int bm_ = bm, bn_ = bn; if (nm % (unsigned)bm_ || nn_ % (unsigned)bn_) { bm_ = 4; bn_ = 8; }
        if (blocked && !r && nm % (unsigned)bm_ == 0 && nn_ % (unsigned)bn_ == 0) { const int bm = bm_, bn = bn_; const unsigned bsz = (unsigned)(bm * bn), blk = (unsigned)L / bsz, w = (unsigned)L - blk * bsz, nbm = nm / (unsigned)bm, bq = blk / nbm, br_ = blk - bq * nbm, wq = w / (unsigned)bm; rem = br_ * bm + (w - wq * bm); q = bq * bn + wq; }
        u.pm = (r ? pm0_1 : pm0_0) + (int)rem; u.pn = (r ? pn0_1 : pn0_0) + (int)q; u.tag = br;
        u.aoff = (long)u.pm * 256 * lda2 + br * abr; u.boff = (long)u.pn * 256 * ldb2 + br * bbr; return true;
    }
};
struct ChainSched {
    int G, c, nM, ntl, nsl, per; long lda2, ldb2, ksl;
    __device__ __forceinline__ bool next(int i, Unit& u) const {
        if (i >= per) return false;
        const unsigned q = (unsigned)(c * per + i), tile = q / (unsigned)nsl, sl = q - tile * (unsigned)nsl; if ((int)tile >= ntl) return false;
        const unsigned pn = tile / (unsigned)nM, pm = tile - pn * (unsigned)nM;
        u.pm = (int)pm; u.pn = (int)pn; u.aoff = (long)pm * 256 * lda2 + sl * ksl; u.boff = (long)pn * 256 * ldb2 + sl * ksl;
        const bool tile_end = (int)sl == nsl - 1, end = tile_end || i == per - 1, from0 = (int)(tile * (unsigned)nsl) >= c * per;
        u.tag = !end ? 0 : (from0 && tile_end) ? 1 : tile_end ? 2 : 3; return true;
    }
};
}

#define XB_TMO      128
#define XB_XCNT(j)  (256  + 64 * (j))
#define XB_XSUB(j)  (1280 + 64 * (j))
#define XB_XGEN(j)  (2304 + 64 * (j))
#define XB_TOP      3328
#define XB_TOPGEN   3392
#define XCD_BAR_WORDS 3456
#define XB_SPIN_CAP (1u << 18)
__device__ __forceinline__ unsigned xb_ld(unsigned* p)              { return __hip_atomic_load(p, __ATOMIC_RELAXED, __HIP_MEMORY_SCOPE_AGENT); }
__device__ __forceinline__ unsigned xb_add(unsigned* p, unsigned v) { return __hip_atomic_fetch_add(p, v, __ATOMIC_RELAXED, __HIP_MEMORY_SCOPE_AGENT); }
__device__ __forceinline__ unsigned xb_xcc_id() { return (unsigned)__builtin_amdgcn_s_getreg((3 << 11) | 20) & 0xFu; }
#define XB_SPIN(cond, bar) do { unsigned _sp = 0; while (cond) { __builtin_amdgcn_s_sleep(1); \
    if ((++_sp & 255u) == 0u) { if (xb_ld(&(bar)[XB_TMO])) break; if (_sp > XB_SPIN_CAP) { atomicAdd(&(bar)[XB_TMO], 1u); break; } } } } while (0)
struct XcdBarrier { unsigned* bar; unsigned x; volatile LAS unsigned* st; unsigned members; };
__device__ __forceinline__ XcdBarrier xcd_barrier_post(unsigned* bar, volatile LAS unsigned* st, unsigned members, bool member) {
    XcdBarrier b; b.bar = bar; b.x = xb_xcc_id(); b.st = st; b.members = members;
    if (!member) return b;
    if (threadIdx.x == 0) (void)xb_add(&bar[XB_XCNT(b.x)], 1u);
    return b;
}
__device__ __forceinline__ void xcd_barrier_complete(unsigned* bar, unsigned x, unsigned G, unsigned& nloc, unsigned& nx) {
    unsigned sum, cnt, mine, sp = 0u;
    for (;;) {
        sum = 0u; cnt = 0u; mine = 0u;
#pragma unroll
        for (unsigned j = 0; j < 16; ++j) { const unsigned c = xb_ld(&bar[XB_XCNT(j)]); sum += c; cnt += (c > 0u) ? 1u : 0u; mine = (j == x) ? c : mine; }
        if (sum == G) break;
        __builtin_amdgcn_s_sleep(1);
        if ((++sp & 255u) == 0u) { if (xb_ld(&bar[XB_TMO])) break; if (sp > XB_SPIN_CAP) { atomicAdd(&bar[XB_TMO], 1u); break; } }
    }
    nloc = mine > 0u ? mine : 1u; nx = cnt > 0u ? cnt : 1u;
}
__device__ __forceinline__ void xcd_barrier(const XcdBarrier& b) {
    asm volatile("s_waitcnt vmcnt(0)" ::: "memory");
    __syncthreads();
    if (threadIdx.x == 0) {
        unsigned* bar = b.bar; unsigned bx_ = b.x; asm volatile("" : "+s"(bx_));
        __builtin_amdgcn_s_waitcnt(0);
        unsigned nloc = b.st[0], nx = b.st[1];
        if (nloc == 0u) { xcd_barrier_complete(bar, bx_, b.members, nloc, nx); b.st[0] = nloc; b.st[1] = nx; }
        const unsigned old = xb_add(&bar[XB_XSUB(bx_)], 1u);
        const unsigned gen = old / nloc;
        if (old + 1u == (gen + 1u) * nloc) {
            __builtin_amdgcn_fence(__ATOMIC_RELEASE, "agent");
            asm volatile("s_waitcnt vmcnt(0)" ::: "memory");
            const unsigned og = xb_add(&bar[XB_TOP], 1u);
            const unsigned tg = og / nx;
            if (og + 1u == (tg + 1u) * nx) xb_add(&bar[XB_TOPGEN], 1u);
            else XB_SPIN(xb_ld(&bar[XB_TOPGEN]) == tg, bar);
            __builtin_amdgcn_fence(__ATOMIC_ACQUIRE, "agent");
            xb_add(&bar[XB_XGEN(bx_)], 1u);
            asm volatile("s_waitcnt vmcnt(0)" ::: "memory");
        } else {
            XB_SPIN(xb_ld(&bar[XB_XGEN(bx_)]) == gen, bar);
            __builtin_amdgcn_fence(__ATOMIC_ACQUIRE, "agent");
            asm volatile("s_waitcnt vmcnt(0)" ::: "memory");
        }
    }
    __syncthreads();
}

constexpr int NWAVES = 8, NTHR = 512;
constexpr int RING_BYTES = 131072, LDSCTL_OFF = RING_BYTES, MISC_OFF = LDSCTL_OFF + 320, LDS_BYTES = 147456;
constexpr int CW_BAR = 4096, CW_FLAGS = 16384, FLAG_BANK = 288 * 64;

__device__ __forceinline__ unsigned pk2(float lo, float hi) { return (unsigned)f2bf(lo) | ((unsigned)f2bf(hi) << 16); }
__device__ __forceinline__ void transpose_item(const float* W, int K, int N, bf16* WT, int row_off, LAS float* scr, int item, int lane) {
    const int nblk = N / 32, kb = item / nblk, nb = item % nblk, k0 = 64 * kb, n0 = 32 * nb;
#pragma unroll 8
    for (int i = 0; i < 32; ++i) { const int kk = 2 * i + (lane >> 5); scr[kk * 33 + (lane & 31)] = W[(size_t)(k0 + kk) * N + n0 + (lane & 31)]; }
    LDS_WAIT(); asm volatile("" ::: "memory");
    const int c = lane & 7;
#pragma unroll
    for (int j = 0; j < 4; ++j) { const int n = (lane >> 3) + 8 * j; const LAS float* s = scr + (8 * c) * 33 + n;
        v4u o; o.x = pk2(s[0 * 33], s[1 * 33]); o.y = pk2(s[2 * 33], s[3 * 33]); o.z = pk2(s[4 * 33], s[5 * 33]); o.w = pk2(s[6 * 33], s[7 * 33]);
        *(GAS v4u*)(WT + (size_t)(row_off + n0 + n) * K + k0 + 8 * c) = o; }
    LDS_WAIT(); asm volatile("" ::: "memory");
}
__device__ __forceinline__ void transpose_item64(const float* W, int K, int N, bf16* WT, LAS float* scr, int item, int lane) {
    const int nblk = N / 64, kb = item / nblk, nb = item - kb * nblk, k0 = 64 * kb, n0 = 64 * nb;
    const float* src = W + (size_t)(k0 + (lane >> 4)) * N + n0 + (lane & 15) * 4;
    f32x4 v[16];
#pragma unroll
    for (int i = 0; i < 16; ++i) v[i] = *(const f32x4*)(src + (size_t)(4 * i) * N);
#pragma unroll
    for (int i = 0; i < 16; ++i) { const int kk = 4 * i + (lane >> 4); *(LAS f32x4*)(scr + kk * 64 + (((lane & 15) * 4 + 4 * (kk >> 3)) & 63)) = v[i]; }
    LDS_WAIT(); asm volatile("" ::: "memory");
    const int c = lane & 7;
#pragma unroll
    for (int j = 0; j < 8; ++j) { const int n = (lane >> 3) + 8 * j; const LAS float* s = scr + (8 * c) * 64 + ((n + 4 * c) & 63);
        v4u o; o.x = pk2(s[0 * 64], s[1 * 64]); o.y = pk2(s[2 * 64], s[3 * 64]); o.z = pk2(s[4 * 64], s[5 * 64]); o.w = pk2(s[6 * 64], s[7 * 64]);
        *(GAS v4u*)(WT + (size_t)(n0 + n) * K + k0 + 8 * c) = o; }
    LDS_WAIT(); asm volatile("" ::: "memory");
}
__device__ __forceinline__ float wave_sum(float v) {
#pragma unroll
    for (int o = 1; o < 64; o <<= 1) v += __shfl_xor(v, o);
    return v;
}

typedef float f32x2_t __attribute__((ext_vector_type(2))); typedef __bf16 bf16x2_t __attribute__((ext_vector_type(2)));
typedef unsigned u32x2 __attribute__((ext_vector_type(2)));
__device__ __forceinline__ unsigned cvtpk(float lo, float hi) { f32x2_t v = {lo, hi}; bf16x2_t b = __builtin_convertvector(v, bf16x2_t); return __builtin_bit_cast(unsigned, b); }
__device__ __forceinline__ float fast_sigmoid(float x) { return __builtin_amdgcn_rcpf(1.0f + __builtin_amdgcn_exp2f(-1.4426950408889634f * x)); }
__device__ __forceinline__ float fexp(float x) { return __builtin_amdgcn_exp2f(x * 1.4426950408889634f); }
__device__ __forceinline__ float flog(float x) { return __builtin_amdgcn_logf(x) * 0.6931471805599453f; }
__device__ __forceinline__ float ftanh(float x) { return 1.0f - 2.0f * __builtin_amdgcn_rcpf(1.0f + fexp(2.0f * x)); }
__device__ __forceinline__ float bflo(unsigned w) { return __builtin_bit_cast(float, w << 16); }
__device__ __forceinline__ float bfhi(unsigned w) { return __builtin_bit_cast(float, w & 0xffff0000u); }
#define EPI_LOOP(...) \
    _Pragma("unroll") for (int ai = 0; ai < 2; ++ai) _Pragma("unroll") for (int m = 0; m < 4; ++m) { const int row = u.pm * 256 + ai * 128 + wr * 64 + m * 16 + fr; \
        _Pragma("unroll") for (int bj = 0; bj < 2; ++bj) _Pragma("unroll") for (int n = 0; n < 2; ++n) { const int col0 = u.pn * 256 + bj * 128 + wc * 32 + fq * 8 + n * 4; f32x4 v = acc[ai][bj][m][n]; __VA_ARGS__ } \
        asm volatile("" ::: "memory"); }
#define EPI_LOOP8(...) \
    _Pragma("unroll") for (int ai = 0; ai < 2; ++ai) _Pragma("unroll") for (int m = 0; m < 4; ++m) { const int row = u.pm * 256 + ai * 128 + wr * 64 + m * 16 + fr; \
        _Pragma("unroll") for (int bj = 0; bj < 2; ++bj) { const int col0 = u.pn * 256 + bj * 128 + wc * 32 + fq * 8; f32x4 v0 = acc[ai][bj][m][0], v1 = acc[ai][bj][m][1]; __VA_ARGS__ } \
        asm volatile("" ::: "memory"); }
struct DEpiPX { bf16* PX; const float* ROPE; bf16* KR;
    __device__ __forceinline__ bool operator()(f32x4 (&acc)[2][2][4][2], const pg8::Unit& u, int wr, int wc, int fr, int fq) const {
        const bool lat = u.pm * 256 < C::MX;
        EPI_LOOP8({ if (col0 >= C::O_GATE) {
                _Pragma("unroll") for (int e = 0; e < 4; ++e) { v0[e] = fmaxf(fast_sigmoid(v0[e]), 1e-6f); v1[e] = fmaxf(fast_sigmoid(v1[e]), 1e-6f); } }
            else if (lat && ((col0 >= C::O_KV && col0 < C::O_KV + C::AKVW) || (col0 >= C::O_Q && col0 < C::O_Q + C::BW))) {
                const int d = (col0 - (col0 >= C::O_Q ? C::O_Q : C::O_KV)) & (C::AH - 1), half = d >> 5, dp = d & 31, i0 = dp & 15; const bool first = dp < 16;
                const float* rp = ROPE + ((size_t)(row % C::S) * (C::AH / 2) + half * (C::AH / 4) + i0) * 2;
                const f32x4 c0 = *(const f32x4*)(rp), c1 = *(const f32x4*)(rp + 4), c2 = *(const f32x4*)(rp + 8), c3 = *(const f32x4*)(rp + 12);
                f32x4 p0, p1;
                _Pragma("unroll") for (int e = 0; e < 4; ++e) { p0[e] = __shfl_xor(v0[e], 32); p1[e] = __shfl_xor(v1[e], 32); }
                const float sg = first ? -1.0f : 1.0f;
                v0[0] = v0[0] * c0[0] + sg * p0[0] * c0[1]; v0[1] = v0[1] * c0[2] + sg * p0[1] * c0[3]; v0[2] = v0[2] * c1[0] + sg * p0[2] * c1[1]; v0[3] = v0[3] * c1[2] + sg * p0[3] * c1[3];
                v1[0] = v1[0] * c2[0] + sg * p1[0] * c2[1]; v1[1] = v1[1] * c2[2] + sg * p1[1] * c2[3]; v1[2] = v1[2] * c3[0] + sg * p1[2] * c3[1]; v1[3] = v1[3] * c3[2] + sg * p1[3] * c3[3]; }
            v4u w; w.x = cvtpk(v0[0], v0[1]); w.y = cvtpk(v0[2], v0[3]); w.z = cvtpk(v1[0], v1[1]); w.w = cvtpk(v1[2], v1[3]);
            if (col0 >= C::O_KV && col0 < C::O_KV + C::AKVW) *(v4u*)(KR + (unsigned)(row * C::AKVW + (col0 - C::O_KV))) = w; else *(v4u*)(PX + (unsigned)(row * C::PXW + col0)) = w; })
        return true;
    } };
struct DEpiMerge { const bf16* PX; bf16* MIX;
    __device__ __forceinline__ bool operator()(f32x4 (&acc)[2][2][4][2], const pg8::Unit& u, int wr, int wc, int fr, int fq) const {
        const int i = u.tag;
#pragma unroll
        for (int ai = 0; ai < 2; ++ai) {
            v4u gt[4][2], pr[4][2];
#pragma unroll
            for (int m = 0; m < 4; ++m) { const int row = u.pm * 256 + ai * 128 + wr * 64 + m * 16 + fr;
#pragma unroll
                for (int bj = 0; bj < 2; ++bj) { const int col0 = u.pn * 256 + bj * 128 + wc * 32 + fq * 8;
                    gt[m][bj] = *(const v4u*)(PX + (unsigned)(row * C::PXW + C::O_GATE + i * C::D + col0));
                    if (i > 0) pr[m][bj] = *(const v4u*)(MIX + (unsigned)(row * C::D + col0)); } }
#pragma unroll
            for (int m = 0; m < 4; ++m) { const int row = u.pm * 256 + ai * 128 + wr * 64 + m * 16 + fr;
#pragma unroll
                for (int bj = 0; bj < 2; ++bj) { const int col0 = u.pn * 256 + bj * 128 + wc * 32 + fq * 8; f32x4 v0 = acc[ai][bj][m][0], v1 = acc[ai][bj][m][1]; const v4u g = gt[m][bj];
                    v0[0] *= bflo(g.x); v0[1] *= bfhi(g.x); v0[2] *= bflo(g.y); v0[3] *= bfhi(g.y); v1[0] *= bflo(g.z); v1[1] *= bfhi(g.z); v1[2] *= bflo(g.w); v1[3] *= bfhi(g.w);
                    if (i > 0) { const v4u q = pr[m][bj]; v0[0] += bflo(q.x); v0[1] += bfhi(q.x); v0[2] += bflo(q.y); v0[3] += bfhi(q.y); v1[0] += bflo(q.z); v1[1] += bfhi(q.z); v1[2] += bflo(q.w); v1[3] += bfhi(q.w); }
                    v4u w; w.x = cvtpk(v0[0], v0[1]); w.y = cvtpk(v0[2], v0[3]); w.z = cvtpk(v1[0], v1[1]); w.w = cvtpk(v1[2], v1[3]); *(v4u*)(MIX + (unsigned)(row * C::D + col0)) = w; } }
            asm volatile("" ::: "memory");
        }
        return true;
    } };
struct DEpiRes { float* X; const float* MODg; const float* xin; const float* cin;
    __device__ __forceinline__ bool operator()(f32x4 (&acc)[2][2][4][2], const pg8::Unit& u, int wr, int wc, int fr, int fq) const {
        const float* XS = xin ? (u.pm * 256 < C::MX ? xin : cin - (size_t)C::MX * C::D) : X;
        f32x4 g[2][2];
        { const float* gp = MODg + (unsigned)(mod_row<C>(u.pm * 256) * 6 * C::D + u.pn * 256 + wc * 32 + fq * 8);
#pragma unroll
          for (int bj = 0; bj < 2; ++bj)
#pragma unroll
            for (int n = 0; n < 2; ++n) g[bj][n] = *(const f32x4*)(gp + bj * 128 + n * 4); }
#pragma unroll
        for (int ai = 0; ai < 2; ++ai)
#pragma unroll
          for (int mp = 0; mp < 2; ++mp) {
            f32x4 x[2][2][2];
#pragma unroll
            for (int mm = 0; mm < 2; ++mm) { const int row = u.pm * 256 + ai * 128 + wr * 64 + (2 * mp + mm) * 16 + fr; const float* xp = XS + (unsigned)(row * C::D + u.pn * 256 + wc * 32 + fq * 8);
#pragma unroll
                for (int bj = 0; bj < 2; ++bj)
#pragma unroll
                    for (int n = 0; n < 2; ++n) x[mm][bj][n] = *(const f32x4*)(xp + bj * 128 + n * 4); }
#pragma unroll
            for (int mm = 0; mm < 2; ++mm) { const int row = u.pm * 256 + ai * 128 + wr * 64 + (2 * mp + mm) * 16 + fr; float* xp = X + (unsigned)(row * C::D + u.pn * 256 + wc * 32 + fq * 8);
#pragma unroll
                for (int bj = 0; bj < 2; ++bj)
#pragma unroll
                    for (int n = 0; n < 2; ++n) *(f32x4*)(xp + bj * 128 + n * 4) = x[mm][bj][n] + g[bj][n] * acc[ai][bj][2 * mp + mm][n]; }
            asm volatile("" ::: "memory");
          }
        return true;
    } };
struct DEpiResChain { float* X; const float* MODg; unsigned* flags; int nM; const float* xin; const float* cin;
    __device__ __forceinline__ bool operator()(f32x4 (&acc)[2][2][4][2], const pg8::Unit& u, int wr, int wc, int fr, int fq) const {
        if (u.tag == 0) return false;
        unsigned* flag = flags + 64 * (u.pn * nM + u.pm);
        if (u.tag == 3) {
            unsigned spins = 0; while (__hip_atomic_load(flag, __ATOMIC_RELAXED, __HIP_MEMORY_SCOPE_AGENT) == 0u && ++spins < (1u << 22)) __builtin_amdgcn_s_sleep(2);
            __builtin_amdgcn_fence(__ATOMIC_ACQUIRE, "agent"); asm volatile("s_waitcnt vmcnt(0)" ::: "memory");
        }
        DEpiRes inner{X, MODg, u.tag == 3 ? nullptr : xin, cin}; inner(acc, u, wr, wc, fr, fq);
        if (u.tag == 2) {
            asm volatile("s_waitcnt vmcnt(0)" ::: "memory"); __builtin_amdgcn_s_barrier(); asm volatile("" ::: "memory");
            if (threadIdx.x == 0) { __builtin_amdgcn_fence(__ATOMIC_RELEASE, "agent"); asm volatile("s_waitcnt vmcnt(0)" ::: "memory"); __hip_atomic_store(flag, 1u, __ATOMIC_RELAXED, __HIP_MEMORY_SCOPE_AGENT); }
        }
        return true;
    } };
struct DEpiMlp1 { bf16* U;
    __device__ __forceinline__ bool operator()(f32x4 (&acc)[2][2][4][2], const pg8::Unit& u, int wr, int wc, int fr, int fq) const {
        EPI_LOOP8({
            _Pragma("unroll") for (int e = 0; e < 4; ++e) { v0[e] = v0[e] > 0.f ? v0[e] * v0[e] : 0.f; v1[e] = v1[e] > 0.f ? v1[e] * v1[e] : 0.f; }
            v4u w; w.x = cvtpk(v0[0], v0[1]); w.y = cvtpk(v0[2], v0[3]); w.z = cvtpk(v1[0], v1[1]); w.w = cvtpk(v1[2], v1[3]); *(v4u*)(U + (unsigned)(row * C::HID + col0)) = w; })
        return true;
    } };
struct DEpiFno { bf16* FEATS; int L, row0;
    __device__ __forceinline__ bool operator()(f32x4 (&acc)[2][2][4][2], const pg8::Unit& u, int wr, int wc, int fr, int fq) const {
        EPI_LOOP({ const int b = col0 / C::BW, nn = col0 % C::BW; u32x2 w; w.x = cvtpk(v[0], v[1]); w.y = cvtpk(v[2], v[3]);
            *(u32x2*)(FEATS + (unsigned)((row0 + b * L + row) * C::D + nn)) = w; })
        return true;
    } };

constexpr int PS_NSTEP = C::CT + C::S, PS_STEPF = 6 * C::RH;
__device__ __forceinline__ size_t ps_off(int d, int b, int h, int s) { return ((((size_t)d * C::B + b) * C::RNH + h) * PS_NSTEP + s) * PS_STEPF; }
__device__ __forceinline__ int ps_step(int d, bool isc, int t) { return isc ? (d == 0 ? t : C::CT - 1 - t) : C::CT + (d == 0 ? t : C::S - 1 - t); }
constexpr int PREP_ROWS = 32;
__device__ __forceinline__ void prep_phase(const Ctx& c, int l, LAS unsigned char* lds, int tid, int vcu, int G) {
    LAS float* ft = (LAS float*)lds;
    const int ch = tid, h = tid >> 6, cl = tid & 63;
    constexpr int NCH = C::MA / PREP_ROWS;
    float* PS = c.PR();
    for (int unit = vcu; unit < 2 * NCH; unit += G) {
        const int d = unit / NCH, chunk = unit % NCH, row0 = chunk * PREP_ROWS;
        int b, t0, L, base; bool isc; row_info<C>(row0, b, t0, L, base, isc);
        const float* mu = c.mu() + ((size_t)l * 2 + d) * C::SHW;
        const int dt = d == 0 ? 1 : -1;
        { const int fi = tid & 127, lcol = C::O_LORA + d * C::DLW + fi; const float mu_l = mu[3 * C::BW + fi];
#pragma unroll
          for (int q = 0; q < PREP_ROWS / 4; ++q) { const int i = (tid >> 7) + 4 * q, t = t0 + i, tp = t - dt;
              const float fl = bf2f(c.PX()[(size_t)(base + t) * C::PXW + lcol]); const float pl = (tp >= 0 && tp < L) ? bf2f(c.PX()[(size_t)(base + tp) * C::PXW + lcol]) : 0.f;
              const float m = fl + mu_l * (pl - fl); ft[i * 128 + fi] = fi < C::DL ? ftanh(m) : m; } }
        __syncthreads();
        float wreg[C::DL];
#pragma unroll
        for (int j = 0; j < C::DL; ++j) wreg[j] = (c.w_up() + (((size_t)l * 2 + d) * C::DL + j) * C::BW)[(unsigned)ch];
        { const float w0 = c.w0()[((size_t)l * 2 + d) * C::BW + ch];
#pragma unroll 1
          for (int i = 0; i < PREP_ROWS; ++i) { float wr = w0;
#pragma unroll
              for (int j = 0; j < C::DL; j += 4) { const f32x4 x = *(const LAS f32x4*)(ft + i * 128 + j); wr += x[0] * wreg[j] + x[1] * wreg[j + 1] + x[2] * wreg[j + 2] + x[3] * wreg[j + 3]; }
              const float z = -wr; const float sp = (z > 0.f ? z : 0.f) + flog(1.0f + fexp(-fabsf(z)));
              PS[ps_off(d, b, h, ps_step(d, isc, t0 + i)) + C::RH + cl] = fexp(-fexp(-sp - 0.5f)); } }
#pragma unroll
        for (int j = 0; j < C::AL; ++j) wreg[j] = (c.a_up() + (((size_t)l * 2 + d) * C::AL + j) * C::BW)[(unsigned)ch];
        { const float mu_r = mu[ch], mu_k = mu[C::BW + ch], mu_v = mu[2 * C::BW + ch];
          const float a0 = c.a0()[((size_t)l * 2 + d) * C::BW + ch], kkw = c.k_k()[l * C::BW + ch], kaw = c.k_a()[l * C::BW + ch];
          const int tfirst = d == 0 ? t0 : t0 + PREP_ROWS - 1, tprev = tfirst - dt;
          float pr = 0.f, pk = 0.f, pv = 0.f;
          if (tprev >= 0 && tprev < L) { const bf16* p = c.PX() + (size_t)(base + tprev) * C::PXW; pr = bf2f(p[ch]); pk = bf2f(p[C::BW + ch]); pv = bf2f(p[2 * C::BW + ch]); }
          bf16 nr, nk, nv;
          { const bf16* p = c.PX() + (size_t)(base + tfirst) * C::PXW; nr = p[ch]; nk = p[C::BW + ch]; nv = p[2 * C::BW + ch]; }
#pragma unroll 1
          for (int i = 0; i < PREP_ROWS; ++i) {
              const int t = tfirst + dt * i;
              const float fr_ = bf2f(nr), fk_ = bf2f(nk), fv_ = bf2f(nv);
              if (i + 1 < PREP_ROWS) { const bf16* p = c.PX() + (size_t)(base + t + dt) * C::PXW; nr = p[ch]; nk = p[C::BW + ch]; nv = p[2 * C::BW + ch]; }
              const float r = fr_ + mu_r * (pr - fr_), k = fk_ + mu_k * (pk - fk_), v = fv_ + mu_v * (pv - fv_);
              pr = fr_; pk = fk_; pv = fv_;
              float ar = a0; const LAS float* fp = ft + (t - t0) * 128 + C::DL;
#pragma unroll
              for (int j = 0; j < C::AL; j += 4) { const f32x4 x = *(const LAS f32x4*)(fp + j); ar += x[0] * wreg[j] + x[1] * wreg[j + 1] + x[2] * wreg[j + 2] + x[3] * wreg[j + 3]; }
              const float a = fast_sigmoid(ar);
              const float kv = k * kkw; const float ss = wave_sum(kv * kv); const float nrm = sqrtf(ss);
              const float kk = kv * __builtin_amdgcn_rcpf(nrm > 1e-12f ? nrm : 1e-12f); const float krep = k * (1.0f + (a - 1.0f) * kaw);
              float* o = PS + ps_off(d, b, h, ps_step(d, isc, t)) + cl;
              o[0] = kk; o[2 * C::RH] = kk * a; o[3 * C::RH] = krep; o[4 * C::RH] = r; o[5 * C::RH] = v;
          } }
        __syncthreads();
    }
}
constexpr int RO_ROWS = 16;
struct RoIn { float y0, y1, r0, k0, v0, r1, k1, v1; bf16 gi; };
__device__ __forceinline__ RoIn ro_load(const Ctx& c, int row, int ch, int tid) {
    int b, t, L, base; bool isc; row_info<C>(row, b, t, L, base, isc);
    const int h = ch >> 6, cl = ch & 63; const float* PS = c.PR();
    const float* p0 = PS + ps_off(0, b, h, ps_step(0, isc, t)) + cl; const float* p1 = PS + ps_off(1, b, h, ps_step(1, isc, t)) + cl;
    RoIn x; x.y0 = c.Y()[(size_t)row * C::BW + ch]; x.y1 = c.Y()[((size_t)C::MA + row) * C::BW + ch];
    x.r0 = p0[4 * C::RH]; x.k0 = p0[3 * C::RH]; x.v0 = p0[5 * C::RH]; x.r1 = p1[4 * C::RH]; x.k1 = p1[3 * C::RH]; x.v1 = p1[5 * C::RH];
    x.gi = c.PX()[(size_t)row * C::PXW + C::O_G + (tid < C::GL ? tid : 0)]; return x;
}
__device__ __forceinline__ void readout_phase(const Ctx& c, int l, int nrows, LAS unsigned char* lds, int tid, int vcu, int G) {
    LAS float* lb = (LAS float*)lds;
    const int ch = tid, h = tid >> 6;
    float greg[C::GL];
#pragma unroll
    for (int j = 0; j < C::GL; ++j) greg[j] = (c.g_up() + ((size_t)l * C::GL + j) * C::BW)[(unsigned)ch];
    const float lg = c.lnx_g()[l * C::BW + ch], lbb = c.lnx_b()[l * C::BW + ch];
    const float rk0 = c.r_k()[(((size_t)l * 2 + 0) * C::RNH + h) * C::RH + (ch & 63)], rk1 = c.r_k()[(((size_t)l * 2 + 1) * C::RNH + h) * C::RH + (ch & 63)];
    int cur = 0;
    for (int unit = vcu; unit < nrows / RO_ROWS; unit += G) {
        RoIn nx = ro_load(c, unit * RO_ROWS, ch, tid);
        for (int i = 0; i < RO_ROWS; ++i) {
            const int row = unit * RO_ROWS + i; const RoIn x = nx;
            if (i + 1 < RO_ROWS) nx = ro_load(c, row + 1, ch, tid);
            if (tid < C::GL) lb[cur * 128 + tid] = fast_sigmoid(bf2f(x.gi));
            const float y = x.y0 + x.y1;
            const float mean = wave_sum(y) * (1.0f / C::RH); const float dv = y - mean; const float var = wave_sum(dv * dv) * (1.0f / C::RH);
            const float yn = dv * __builtin_amdgcn_rsqf(var + 64e-5f) * lg + lbb;
            const float s0 = wave_sum(x.r0 * x.k0 * rk0), s1 = wave_sum(x.r1 * x.k1 * rk1);
            const float bonus = s0 * x.v0 + s1 * x.v1;
            __syncthreads();
            float g = 0.f;
#pragma unroll
            for (int j = 0; j < C::GL; j += 4) { const f32x4 xx = *(const LAS f32x4*)(lb + cur * 128 + j); g += xx[0] * greg[j] + xx[1] * greg[j + 1] + xx[2] * greg[j + 2] + xx[3] * greg[j + 3]; if ((j & 12) == 12) asm volatile("" ::: "memory"); }
            c.FEATS()[(size_t)row * C::D + C::BW + ch] = f2bf((yn + bonus) * g);
            cur ^= 1;
        }
    }
    __syncthreads();
}
typedef float f32x16 __attribute__((ext_vector_type(16)));
typedef short s16x4 __attribute__((ext_vector_type(4)));
constexpr int AT_KSTR = 144, AT_VSTR = 648, AT_KOFF = 0, AT_VOFF = 320 * AT_KSTR;
__device__ __forceinline__ void attn_unit(const Ctx& c, int l, LAS unsigned char* lds, int tid, int b, int g, int qrow0, int tq0, bool ctxq) {
    const int lane = tid & 63, wave = __builtin_amdgcn_readfirstlane(tid >> 6), hl = wave >> 1, qh = wave & 1, ql = lane & 31, hi = lane >> 5;
    const int h = g * C::AREP + hl, qrow = qrow0 + 32 * qh + ql, tq = tq0 + 32 * qh + ql;
    bf16x8 qf[4];
#pragma unroll
    for (int s_ = 0; s_ < 4; ++s_) qf[s_] = *(const bf16x8*)(c.PX() + (size_t)qrow * C::PXW + C::O_Q + h * C::AH + 16 * s_ + 8 * hi);
    float m = c.sink()[l * C::ANH + h], lsum = hi == 0 ? 1.0f : 0.0f;
    f32x16 o0 = {}, o1 = {};
    const int npass = ctxq ? 1 : 2;
    for (int pass = 0; pass < npass; ++pass) {
        const int nk = pass == 0 ? C::CT : 2 * C::WIN + 64; const int jbase = tq0 - C::WIN;
        for (int it = tid; it < nk * 8; it += NTHR) {
            const int key = it >> 3, chn = it & 7; int row; bool valid = true;
            if (pass == 0) row = C::MX + b * C::CT + key; else { const int j = jbase + key; valid = j >= 0 && j < C::S; row = b * C::S + j; }
            v4u val = {0u, 0u, 0u, 0u};
            if (valid) val = *(const v4u*)(c.KR() + (size_t)row * C::AKVW + g * C::AH + chn * 8);
            *(LAS v4u*)(lds + AT_KOFF + key * AT_KSTR + chn * 16) = val;
        }
        for (int it = tid; it < nk * 8; it += NTHR) {
            const int dch = it / nk, key = it - dch * nk; int row; bool valid = true;
            if (pass == 0) row = C::MX + b * C::CT + key; else { const int j = jbase + key; valid = j >= 0 && j < C::S; row = b * C::S + j; }
            v4u val = {0u, 0u, 0u, 0u};
            if (valid) val = *(const v4u*)(c.PX() + (size_t)row * C::PXW + C::O_KV + C::AKVW + g * C::AH + dch * 8);
            LAS unsigned short* vt = (LAS unsigned short*)(lds + AT_VOFF) + (dch * 8) * (AT_VSTR / 2) + key;
            vt[0 * (AT_VSTR / 2)] = (unsigned short)(val.x & 0xffffu); vt[1 * (AT_VSTR / 2)] = (unsigned short)(val.x >> 16);
            vt[2 * (AT_VSTR / 2)] = (unsigned short)(val.y & 0xffffu); vt[3 * (AT_VSTR / 2)] = (unsigned short)(val.y >> 16);
            vt[4 * (AT_VSTR / 2)] = (unsigned short)(val.z & 0xffffu); vt[5 * (AT_VSTR / 2)] = (unsigned short)(val.z >> 16);
            vt[6 * (AT_VSTR / 2)] = (unsigned short)(val.w & 0xffffu); vt[7 * (AT_VSTR / 2)] = (unsigned short)(val.w >> 16);
        }
        __syncthreads();
        const int qa = tq0 + 32 * qh;
        for (int kt = 0; kt < nk / 32; ++kt) {
            const int jb = jbase + 32 * kt;
            if (pass == 1 && (jb + 31 < qa - C::WIN || jb > qa + 31 + C::WIN)) continue;
            f32x16 sacc = {};
#pragma unroll
            for (int s_ = 0; s_ < 4; ++s_) { const bf16x8 kf = *(const LAS bf16x8*)(lds + AT_KOFF + (32 * kt + ql) * AT_KSTR + (16 * s_ + 8 * hi) * 2);
                sacc = __builtin_amdgcn_mfma_f32_32x32x16_bf16(kf, qf[s_], sacc, 0, 0, 0); }
            float mx = -1e30f;
#pragma unroll
            for (int r = 0; r < 16; ++r) { float sv = sacc[r] * 0.125f;
                if (pass == 1) { const int j = jb + (r & 3) + 8 * (r >> 2) + 4 * hi; const int dj = j - tq; if (j < 0 || j >= C::S || dj > C::WIN || dj < -C::WIN) sv = -1e30f; }
                sacc[r] = sv; mx = fmaxf(mx, sv); }
            mx = fmaxf(mx, __shfl_xor(mx, 32));
            const float mn = fmaxf(m, mx), f = __builtin_amdgcn_exp2f((m - mn) * 1.4426950408889634f); m = mn;
            float ps = 0.f;
#pragma unroll
            for (int r = 0; r < 16; ++r) { const float p = __builtin_amdgcn_exp2f((sacc[r] - mn) * 1.4426950408889634f); sacc[r] = p; ps += p; }
            lsum = lsum * f + ps;
#pragma unroll
            for (int r = 0; r < 16; ++r) { o0[r] *= f; o1[r] *= f; }
            bf16x8 pb[2];
#pragma unroll
            for (int s_ = 0; s_ < 2; ++s_) { v4u w; w.x = cvtpk(sacc[8 * s_ + 0], sacc[8 * s_ + 1]); w.y = cvtpk(sacc[8 * s_ + 2], sacc[8 * s_ + 3]); w.z = cvtpk(sacc[8 * s_ + 4], sacc[8 * s_ + 5]); w.w = cvtpk(sacc[8 * s_ + 6], sacc[8 * s_ + 7]);
                pb[s_] = __builtin_bit_cast(bf16x8, w); }
#pragma unroll
            for (int s_ = 0; s_ < 2; ++s_) {
                const LAS unsigned char* vp = lds + AT_VOFF + ql * AT_VSTR + (32 * kt + 16 * s_ + 4 * hi) * 2;
                const s16x4 a0 = *(const LAS s16x4*)(vp), a1 = *(const LAS s16x4*)(vp + 16);
                const s16x4 b0 = *(const LAS s16x4*)(vp + 32 * AT_VSTR), b1 = *(const LAS s16x4*)(vp + 32 * AT_VSTR + 16);
                const bf16x8 va0 = {a0[0], a0[1], a0[2], a0[3], a1[0], a1[1], a1[2], a1[3]}, va1 = {b0[0], b0[1], b0[2], b0[3], b1[0], b1[1], b1[2], b1[3]};
                o0 = __builtin_amdgcn_mfma_f32_32x32x16_bf16(va0, pb[s_], o0, 0, 0, 0);
                o1 = __builtin_amdgcn_mfma_f32_32x32x16_bf16(va1, pb[s_], o1, 0, 0, 0);
            }
        }
        __syncthreads();
    }
    const float lt = lsum + __shfl_xor(lsum, 32), inv = 1.0f / lt;
    bf16* op = c.FEATS() + (size_t)qrow * C::D + 2 * C::BW + h * C::AH;
#pragma unroll
    for (int r4 = 0; r4 < 4; ++r4) {
        u32x2 w0, w1; w0.x = cvtpk(o0[4 * r4] * inv, o0[4 * r4 + 1] * inv); w0.y = cvtpk(o0[4 * r4 + 2] * inv, o0[4 * r4 + 3] * inv);
        w1.x = cvtpk(o1[4 * r4] * inv, o1[4 * r4 + 1] * inv); w1.y = cvtpk(o1[4 * r4 + 2] * inv, o1[4 * r4 + 3] * inv);
        *(u32x2*)(op + 8 * r4 + 4 * hi) = w0; *(u32x2*)(op + 32 + 8 * r4 + 4 * hi) = w1;
    }
}
__device__ __forceinline__ void attn_phase(const Ctx& c, int l, bool wc, LAS unsigned char* lds, int tid, int vcu, int G) {
    constexpr int NQB = C::S / 64, NXU = C::B * C::AKV * NQB, NCB = C::CT / 64, NCU = C::B * C::AKV * NCB;
    for (int u = vcu; u < NXU + (wc ? NCU : 0); u += G) {
        if (u < NXU) { const int qb = u % NQB, g = (u / NQB) % C::AKV, b = u / (NQB * C::AKV); attn_unit(c, l, lds, tid, b, g, b * C::S + qb * 64, qb * 64, false); }
        else { const int u2 = u - NXU; const int qb = u2 % NCB, g = (u2 / NCB) % C::AKV, b = u2 / (NCB * C::AKV); attn_unit(c, l, lds, tid, b, g, C::MX + b * C::CT + qb * 64, qb * 64, true); }
    }
}

constexpr int SC_STEPS = 32, SC_STEPB = PS_STEPF * 4, SC_BUFB = SC_STEPS * SC_STEPB;
template <int N> __device__ __forceinline__ float dpp_ror_add(float x) { const int y = __builtin_amdgcn_update_dpp(0, __builtin_bit_cast(int, x), 0x120 + N, 0xF, 0xF, false); return x + __builtin_bit_cast(float, y); }
__device__ __forceinline__ float row16_sum(float x) { x = dpp_ror_add<8>(x); x = dpp_ror_add<4>(x); x = dpp_ror_add<2>(x); x = dpp_ror_add<1>(x); return x; }
__device__ __forceinline__ int scan_row(int d, int b, int s) {
    if (s < C::CT) return C::MX + b * C::CT + (d == 0 ? s : C::CT - 1 - s);
    const int i = s - C::CT; return b * C::S + (d == 0 ? i : C::S - 1 - i);
}
struct ScanOps { f32x4 kk, w, kka, kr, r; float vv; };
__device__ __forceinline__ ScanOps scan_ld(const LAS unsigned char* p, int kg, int vr) {
    ScanOps o; o.kk = *(const LAS f32x4*)(p + kg * 16); o.w = *(const LAS f32x4*)(p + 256 + kg * 16); o.kka = *(const LAS f32x4*)(p + 512 + kg * 16);
    o.kr = *(const LAS f32x4*)(p + 768 + kg * 16); o.r = *(const LAS f32x4*)(p + 1024 + kg * 16); o.vv = *(const LAS float*)(p + 1280 + vr * 4); return o;
}
__device__ __forceinline__ void scan_phase(const Ctx& c, bool emit_ctx, LAS unsigned char* lds, int tid, int ucu, int UG) {
    const int lane = tid & 63, wave = __builtin_amdgcn_readfirstlane(tid >> 6);
    constexpr int NCHUNK = PS_NSTEP / SC_STEPS, NUNIT = 2 * C::B * C::RNH * 2, NPC = SC_BUFB / 1024 / NWAVES;
    for (int unit = ucu; unit < NUNIT; unit += UG) {
        const int hq = unit & 1, chain = unit >> 1, h = chain % C::RNH, b = (chain / C::RNH) % C::B, d = chain / (C::RNH * C::B);
        const float* src = c.PR() + ps_off(d, b, h, 0) + (size_t)wave * NPC * 256 + lane * 4;
#define SC_DMA(chunk, bufi) do { _Pragma("unroll") for (int q = 0; q < NPC; ++q) \
            __builtin_amdgcn_global_load_lds((const unsigned*)(src + (size_t)(chunk) * (SC_BUFB / 4) + q * 256), (LAS unsigned*)(lds + (bufi) * SC_BUFB + (wave * NPC + q) * 1024), 16, 0, 0); } while (0)
        const int kg = lane & 15, rloc = lane >> 4, vrow = 32 * hq + 4 * wave + rloc;
        float* yb = c.Y() + (size_t)d * C::MA * C::BW + h * C::RH + vrow;
        f32x4 S = {0.f, 0.f, 0.f, 0.f};
        SC_DMA(0, 0);
        asm volatile("s_waitcnt vmcnt(0)" ::: "memory"); __syncthreads();
        for (int k = 0; k < NCHUNK; ++k) {
            if (k + 1 < NCHUNK) SC_DMA(k + 1, (k + 1) & 1);
            const LAS unsigned char* bp = lds + (k & 1) * SC_BUFB;
            const bool emit = emit_ctx || k >= C::CT / SC_STEPS;
            const int row_k = scan_row(d, b, k * SC_STEPS), dt = d == 0 ? 1 : -1;
            ScanOps cur = scan_ld(bp, kg, vrow);
            float ykeep = 0.f;
#pragma unroll 2
            for (int s_ = 0; s_ < SC_STEPS; ++s_) {
                const ScanOps nx = scan_ld(bp + (s_ + 1 < SC_STEPS ? s_ + 1 : s_) * SC_STEPB, kg, vrow);
                float sa = -((S[0] * cur.kk[0] + S[1] * cur.kk[1]) + (S[2] * cur.kk[2] + S[3] * cur.kk[3]));
                sa = row16_sum(sa);
                S = S * cur.w + (sa * cur.kka + cur.vv * cur.kr);
                float y = (S[0] * cur.r[0] + S[1] * cur.r[1]) + (S[2] * cur.r[2] + S[3] * cur.r[3]);
                y = row16_sum(y);
                ykeep = (kg == (s_ & 15)) ? y : ykeep;
                if ((s_ & 15) == 15 && emit) yb[(size_t)(row_k + dt * ((s_ & ~15) + kg)) * C::BW] = ykeep;
                cur = nx;
            }
            asm volatile("s_waitcnt vmcnt(0)" ::: "memory"); __syncthreads();
        }
#undef SC_DMA
    }
}

template <int CTRL> __device__ __forceinline__ float dpp_add(float x) { const int y = __builtin_amdgcn_update_dpp(0, __builtin_bit_cast(int, x), CTRL, 0xF, 0xF, false); return x + __builtin_bit_cast(float, y); }
__device__ __forceinline__ float row8_sum(float x) { x = dpp_add<0xB1>(x); x = dpp_add<0x4E>(x); x = dpp_add<0x141>(x); return x; }
struct ScanOps8 { f32x4 kk0, kk1, w0, w1, ka0, ka1, kr0, kr1, r0, r1; float vv; };
__device__ __forceinline__ ScanOps8 scan_ld8(const LAS unsigned char* p, int kg, int vr) {
    ScanOps8 o; const LAS unsigned char* q = p + kg * 32;
    o.kk0 = *(const LAS f32x4*)(q); o.kk1 = *(const LAS f32x4*)(q + 16); o.w0 = *(const LAS f32x4*)(q + 256); o.w1 = *(const LAS f32x4*)(q + 272);
    o.ka0 = *(const LAS f32x4*)(q + 512); o.ka1 = *(const LAS f32x4*)(q + 528); o.kr0 = *(const LAS f32x4*)(q + 768); o.kr1 = *(const LAS f32x4*)(q + 784);
    o.r0 = *(const LAS f32x4*)(q + 1024); o.r1 = *(const LAS f32x4*)(q + 1040); o.vv = *(const LAS float*)(p + 1280 + vr * 4); return o;
}
__device__ __forceinline__ float hsum4(f32x4 a) { return (a[0] + a[1]) + (a[2] + a[3]); }
__device__ __forceinline__ void scan64_phase(const Ctx& c, bool emit_ctx, LAS unsigned char* lds, int tid, int ucu, int UG) {
    const int lane = tid & 63, wave = __builtin_amdgcn_readfirstlane(tid >> 6);
    constexpr int NCHUNK = PS_NSTEP / SC_STEPS, NUNIT = 2 * C::B * C::RNH, NPC = SC_BUFB / 1024 / NWAVES;
    for (int unit = ucu; unit < NUNIT; unit += UG) {
        const int chain = unit, h = chain % C::RNH, b = (chain / C::RNH) % C::B, d = chain / (C::RNH * C::B);
        const float* src = c.PR() + ps_off(d, b, h, 0) + (size_t)wave * NPC * 256 + lane * 4;
#define SC_FLUSH(kc) do { const int st_ = tid >> 4, part_ = tid & 15; const int rowf_ = scan_row(d, b, (kc) * SC_STEPS) + (d == 0 ? st_ : -st_); \
            *(f32x4*)(yg + (size_t)rowf_ * C::BW + part_ * 4) = *(const LAS f32x4*)(ybuf + (((kc) & 1) * SC_STEPS + st_) * C::RH + part_ * 4); } while (0)
#define SC_DMA(chunk, bufi) do { _Pragma("unroll") for (int q = 0; q < NPC; ++q) \
            __builtin_amdgcn_global_load_lds((const unsigned*)(src + (size_t)(chunk) * (SC_BUFB / 4) + q * 256), (LAS unsigned*)(lds + (bufi) * SC_BUFB + (wave * NPC + q) * 1024), 16, 0, 0); } while (0)
        const int kg = lane & 7, rloc = lane >> 3, vrow = 8 * wave + rloc;
        float* yg = c.Y() + (size_t)d * C::MA * C::BW + h * C::RH;
        LAS float* ybuf = (LAS float*)(lds + 2 * SC_BUFB);
        f32x4 S0 = {0.f, 0.f, 0.f, 0.f}, S1 = {0.f, 0.f, 0.f, 0.f};
        SC_DMA(0, 0);
        asm volatile("s_waitcnt vmcnt(0)" ::: "memory"); __syncthreads();
        for (int k = 0; k < NCHUNK; ++k) {
            if (k + 1 < NCHUNK) SC_DMA(k + 1, (k + 1) & 1);
            if (k > 0 && (emit_ctx || k - 1 >= C::CT / SC_STEPS)) SC_FLUSH(k - 1);
            const LAS unsigned char* bp = lds + (k & 1) * SC_BUFB;
            const bool emit = emit_ctx || k >= C::CT / SC_STEPS;
            const int row_k = scan_row(d, b, k * SC_STEPS), dt = d == 0 ? 1 : -1;
            const LAS unsigned char* pp = bp + kg * 32; const LAS unsigned char* pv = bp + 1280 + vrow * 4;
#define SC_LD8(o) do { o.kk0 = *(const LAS f32x4*)(pp); o.kk1 = *(const LAS f32x4*)(pp + 16); o.w0 = *(const LAS f32x4*)(pp + 256); o.w1 = *(const LAS f32x4*)(pp + 272); \
                o.ka0 = *(const LAS f32x4*)(pp + 512); o.ka1 = *(const LAS f32x4*)(pp + 528); o.kr0 = *(const LAS f32x4*)(pp + 768); o.kr1 = *(const LAS f32x4*)(pp + 784); \
                o.r0 = *(const LAS f32x4*)(pp + 1024); o.r1 = *(const LAS f32x4*)(pp + 1040); o.vv = *(const LAS float*)(pv); pp += SC_STEPB; pv += SC_STEPB; } while (0)
#define SC_STEP(o, s_) do { \
                float sa = -hsum4(S0 * o.kk0 + S1 * o.kk1); \
                sa = row8_sum(sa); \
                S0 = S0 * o.w0 + (sa * o.ka0 + o.vv * o.kr0); S1 = S1 * o.w1 + (sa * o.ka1 + o.vv * o.kr1); \
                float y = hsum4(S0 * o.r0 + S1 * o.r1); \
                y = row8_sum(y); \
                ykeep = (kg == ((s_) & 7)) ? y : ykeep; \
                if (((s_) & 7) == 7) ybuf[((k & 1) * SC_STEPS + ((s_) & ~7) + kg) * C::RH + vrow] = ykeep; } while (0)
            ScanOps8 ob3[3]; SC_LD8(ob3[0]); SC_LD8(ob3[1]);
            float ykeep = 0.f;
#pragma unroll
            for (int s_ = 0; s_ < SC_STEPS; ++s_) {
                if (s_ + 2 < SC_STEPS) SC_LD8(ob3[(s_ + 2) % 3]);
                SC_STEP(ob3[s_ % 3], s_);
            }
#undef SC_LD8
#undef SC_STEP
            asm volatile("s_waitcnt vmcnt(0)" ::: "memory"); __syncthreads();
        }
        SC_FLUSH(NCHUNK - 1);
        __syncthreads();
#undef SC_DMA
#undef SC_FLUSH
    }
}

constexpr int PM_FSTR = 272, PM_XSTR = 3 * C::BW * 2 + 16, PM_XOFF = 32 * PM_FSTR;
__device__ __forceinline__ float half32_sum(float x) { x = row16_sum(x); return x + __shfl_xor(x, 16); }
__device__ __forceinline__ void prep_mfma_phase(const Ctx& c, int l, LAS unsigned char* lds, int tid, int vcu, int G) {
    const int lane = tid & 63, h = __builtin_amdgcn_readfirstlane(tid >> 6), ql = lane & 31, hi = lane >> 5;
    constexpr int NCH = C::MA / 32;
    const int d = vcu & 1, dt = d == 0 ? 1 : -1;
    float* PS = c.PR();
    const float* mu = c.mu() + ((size_t)l * 2 + d) * C::SHW;
    bf16x8 wB[2][4], aB[2][4]; float w0[2], a0[2], kkw[2], kaw[2], mur[2], muk[2], muv[2], rkd[2];
#pragma unroll
    for (int ct = 0; ct < 2; ++ct) { const int ch = h * C::RH + 32 * ct + ql;
        w0[ct] = c.w0()[((size_t)l * 2 + d) * C::BW + ch]; a0[ct] = c.a0()[((size_t)l * 2 + d) * C::BW + ch]; kkw[ct] = c.k_k()[l * C::BW + ch]; kaw[ct] = c.k_a()[l * C::BW + ch];
        mur[ct] = mu[ch]; muk[ct] = mu[C::BW + ch]; muv[ct] = mu[2 * C::BW + ch]; rkd[ct] = c.r_k()[(((size_t)l * 2 + d) * C::RNH + h) * C::RH + 32 * ct + ql];
#pragma unroll
        for (int s_ = 0; s_ < 4; ++s_) { const float* wp = c.w_up() + (((size_t)l * 2 + d) * C::DL + 16 * s_ + 8 * hi) * C::BW + ch; const float* ap = c.a_up() + (((size_t)l * 2 + d) * C::AL + 16 * s_ + 8 * hi) * C::BW + ch;
            v4u ww, aa; ww.x = cvtpk(wp[0], wp[C::BW]); ww.y = cvtpk(wp[2 * C::BW], wp[3 * C::BW]); ww.z = cvtpk(wp[4 * C::BW], wp[5 * C::BW]); ww.w = cvtpk(wp[6 * C::BW], wp[7 * C::BW]);
            aa.x = cvtpk(ap[0], ap[C::BW]); aa.y = cvtpk(ap[2 * C::BW], ap[3 * C::BW]); aa.z = cvtpk(ap[4 * C::BW], ap[5 * C::BW]); aa.w = cvtpk(ap[6 * C::BW], ap[7 * C::BW]);
            wB[ct][s_] = __builtin_bit_cast(bf16x8, ww); aB[ct][s_] = __builtin_bit_cast(bf16x8, aa); } }
    for (int chunk = vcu >> 1; chunk < NCH; chunk += G >> 1) {
        const int row0 = chunk * 32; int b, t0, L, base; bool isc; row_info<C>(row0, b, t0, L, base, isc);
        const int tlo = d == 0 ? t0 - 1 : t0;
        { const int fi = tid & 127, lcol = C::O_LORA + d * C::DLW + fi; const float mu_l = mu[3 * C::BW + fi];
#pragma unroll
          for (int q = 0; q < 8; ++q) { const int i = (tid >> 7) + 4 * q, t = t0 + i, tp = t - dt;
              const float fl = bf2f(c.PX()[(size_t)(base + t) * C::PXW + lcol]); const float pl = (tp >= 0 && tp < L) ? bf2f(c.PX()[(size_t)(base + tp) * C::PXW + lcol]) : 0.f;
              const float m = fl + mu_l * (pl - fl); *(LAS bf16*)(lds + i * PM_FSTR + fi * 2) = f2bf(fi < C::DL ? ftanh(m) : m); } }
        for (int it = tid; it < 33 * (3 * C::BW / 8); it += NTHR) { const int ti = it / (3 * C::BW / 8), c8 = it - ti * (3 * C::BW / 8), t = tlo + ti;
            v4u val = {0u, 0u, 0u, 0u}; if (t >= 0 && t < L) val = *(const v4u*)(c.PX() + (size_t)(base + t) * C::PXW + c8 * 8);
            *(LAS v4u*)(lds + PM_XOFF + ti * PM_XSTR + c8 * 16) = val; }
        __syncthreads();
        f32x16 accW[2] = {}, accA[2] = {};
#pragma unroll
        for (int s_ = 0; s_ < 4; ++s_) { const bf16x8 fw = *(const LAS bf16x8*)(lds + ql * PM_FSTR + (16 * s_ + 8 * hi) * 2), fa = *(const LAS bf16x8*)(lds + ql * PM_FSTR + (C::DL + 16 * s_ + 8 * hi) * 2);
#pragma unroll
            for (int ct = 0; ct < 2; ++ct) { accW[ct] = __builtin_amdgcn_mfma_f32_32x32x16_bf16(fw, wB[ct][s_], accW[ct], 0, 0, 0); accA[ct] = __builtin_amdgcn_mfma_f32_32x32x16_bf16(fa, aB[ct][s_], accA[ct], 0, 0, 0); } }
#pragma unroll
        for (int r = 0; r < 16; ++r) { const int i = (r & 3) + 8 * (r >> 2) + 4 * hi, t = t0 + i, ti = t - tlo, tip = ti - dt;
            float kx[2], rx[2], vx[2], ss = 0.f;
#pragma unroll
            for (int ct = 0; ct < 2; ++ct) { const int cl = 32 * ct + ql, ch = h * C::RH + cl;
                const LAS bf16* pc = (const LAS bf16*)(lds + PM_XOFF + ti * PM_XSTR) + ch; const LAS bf16* pp = (const LAS bf16*)(lds + PM_XOFF + tip * PM_XSTR) + ch;
                const float fr_ = bf2f(pc[0]), fk_ = bf2f(pc[C::BW]), fv_ = bf2f(pc[2 * C::BW]), pr = bf2f(pp[0]), pk = bf2f(pp[C::BW]), pv = bf2f(pp[2 * C::BW]);
                rx[ct] = fr_ + mur[ct] * (pr - fr_); kx[ct] = fk_ + muk[ct] * (pk - fk_); vx[ct] = fv_ + muv[ct] * (pv - fv_);
                const float kv = kx[ct] * kkw[ct]; ss += kv * kv; }
            ss = half32_sum(ss); const float rn = __builtin_amdgcn_rcpf(fmaxf(sqrtf(ss), 1e-12f));
            float* ob = PS + ps_off(d, b, h, ps_step(d, isc, t)); float bsum = 0.f;
#pragma unroll
            for (int ct = 0; ct < 2; ++ct) { const int cl = 32 * ct + ql;
                const float wr = w0[ct] + accW[ct][r], ar = a0[ct] + accA[ct][r];
                const float z = -wr; const float sp = (z > 0.f ? z : 0.f) + flog(1.0f + fexp(-fabsf(z)));
                const float decay = fexp(-fexp(-sp - 0.5f)), a = fast_sigmoid(ar), kk = kx[ct] * kkw[ct] * rn, krep = kx[ct] * (1.0f + (a - 1.0f) * kaw[ct]);
                bsum += rx[ct] * krep * rkd[ct];
                float* o = ob + cl; o[0] = kk; o[C::RH] = decay; o[2 * C::RH] = kk * a; o[3 * C::RH] = krep; o[4 * C::RH] = rx[ct]; o[5 * C::RH] = vx[ct]; }
            bsum = half32_sum(bsum); if (ql == 0) c.BS()[((size_t)d * C::MA + base + t) * C::RNH + h] = bsum; }
        __syncthreads();
    }
}
__device__ __forceinline__ void readout_mfma_phase(const Ctx& c, int l, int nrows, LAS unsigned char* lds, int tid, int vcu, int G) {
    const int lane = tid & 63, h = __builtin_amdgcn_readfirstlane(tid >> 6), ql = lane & 31, hi = lane >> 5;
    const float* PS = c.PR();
    bf16x8 gB[2][8]; float lg[2], lbb[2], rk0[2], rk1[2];
#pragma unroll
    for (int ct = 0; ct < 2; ++ct) { const int cl = 32 * ct + ql, ch = h * C::RH + cl;
        lg[ct] = c.lnx_g()[l * C::BW + ch]; lbb[ct] = c.lnx_b()[l * C::BW + ch];
        rk0[ct] = c.r_k()[(((size_t)l * 2 + 0) * C::RNH + h) * C::RH + cl]; rk1[ct] = c.r_k()[(((size_t)l * 2 + 1) * C::RNH + h) * C::RH + cl];
#pragma unroll
        for (int s_ = 0; s_ < 8; ++s_) { const float* gp = c.g_up() + ((size_t)l * C::GL + 16 * s_ + 8 * hi) * C::BW + ch;
            v4u ww; ww.x = cvtpk(gp[0], gp[C::BW]); ww.y = cvtpk(gp[2 * C::BW], gp[3 * C::BW]); ww.z = cvtpk(gp[4 * C::BW], gp[5 * C::BW]); ww.w = cvtpk(gp[6 * C::BW], gp[7 * C::BW]);
            gB[ct][s_] = __builtin_bit_cast(bf16x8, ww); } }
    for (int unit = vcu; unit < nrows / 32; unit += G) {
        const int row0 = unit * 32; int b, t0, L, base; bool isc; row_info<C>(row0, b, t0, L, base, isc);
        { const int fi = tid & 127;
#pragma unroll
          for (int q = 0; q < 8; ++q) { const int i = (tid >> 7) + 4 * q;
              *(LAS bf16*)(lds + i * PM_FSTR + fi * 2) = f2bf(fast_sigmoid(bf2f(c.PX()[(size_t)(row0 + i) * C::PXW + C::O_G + fi]))); } }
        __syncthreads();
        f32x16 accG[2] = {};
#pragma unroll
        for (int s_ = 0; s_ < 8; ++s_) { const bf16x8 fa = *(const LAS bf16x8*)(lds + ql * PM_FSTR + (16 * s_ + 8 * hi) * 2);
#pragma unroll
            for (int ct = 0; ct < 2; ++ct) accG[ct] = __builtin_amdgcn_mfma_f32_32x32x16_bf16(fa, gB[ct][s_], accG[ct], 0, 0, 0); }
#pragma unroll
        for (int rg = 0; rg < 4; ++rg) {
            float ya[4][2], yb[4][2], va[4][2], vb[4][2], bs0[4], bs1[4];
#pragma unroll
            for (int rr = 0; rr < 4; ++rr) { const int i = rr + 8 * rg + 4 * hi, row = row0 + i, t = t0 + i;
                const float* p0 = PS + ps_off(0, b, h, ps_step(0, isc, t)); const float* p1 = PS + ps_off(1, b, h, ps_step(1, isc, t));
                const float* y0p = c.Y() + (size_t)row * C::BW + h * C::RH; const float* y1p = c.Y() + ((size_t)C::MA + row) * C::BW + h * C::RH;
                bs0[rr] = c.BS()[(size_t)row * C::RNH + h]; bs1[rr] = c.BS()[((size_t)C::MA + row) * C::RNH + h];
#pragma unroll
                for (int ct = 0; ct < 2; ++ct) { const int cl = 32 * ct + ql; ya[rr][ct] = y0p[cl]; yb[rr][ct] = y1p[cl]; va[rr][ct] = p0[5 * C::RH + cl]; vb[rr][ct] = p1[5 * C::RH + cl]; } }
#pragma unroll
            for (int rr = 0; rr < 4; ++rr) { const int r = 4 * rg + rr, i = rr + 8 * rg + 4 * hi, row = row0 + i;
                float y[2], sm = 0.f; const float s0 = bs0[rr], s1 = bs1[rr];
#pragma unroll
                for (int ct = 0; ct < 2; ++ct) { y[ct] = ya[rr][ct] + yb[rr][ct]; sm += y[ct]; }
                const float mean = half32_sum(sm) * (1.0f / C::RH);
                float sq = 0.f;
#pragma unroll
                for (int ct = 0; ct < 2; ++ct) { y[ct] -= mean; sq += y[ct] * y[ct]; }
                const float rs = __builtin_amdgcn_rsqf(half32_sum(sq) * (1.0f / C::RH) + 64e-5f);
#pragma unroll
                for (int ct = 0; ct < 2; ++ct) { const int cl = 32 * ct + ql;
                    const float yn = y[ct] * rs * lg[ct] + lbb[ct], bonus = s0 * va[rr][ct] + s1 * vb[rr][ct];
                    c.FEATS()[(size_t)row * C::D + C::BW + h * C::RH + cl] = f2bf((yn + bonus) * accG[ct][r]); } }
        }
        __syncthreads();
    }
}
__device__ __forceinline__ void el_tbd(bf16* T, long idx) {
    const int np = (int)(idx / C::BW), k = (int)(idx % C::BW), g = np / (2 * C::FGW), j = np % (2 * C::FGW), g2 = k / C::FGW, cc = k % C::FGW;
    float v = 0.f;
    if (g == g2) { const int jj = j % C::FGW; const float ang = 6.283185307179586f * (float)((jj * cc) % C::FGW) / (float)C::FGW; v = j < C::FGW ? cosf(ang) : -sinf(ang); }
    T[idx] = f2bf(v);
}
struct DEpiFnoA { bf16* YT; bf16* YTC;
    __device__ __forceinline__ bool operator()(f32x4 (&acc)[2][2][4][2], const pg8::Unit& u, int wr, int wc, int fr, int fq) const {
        EPI_LOOP({ int b, t, L, base; bool isc; row_info<C>(row, b, t, L, base, isc);
            const int g = col0 / (2 * C::FGW), j = col0 % (2 * C::FGW), im = j >= C::FGW ? 1 : 0, n = g * C::FGW + (j - im * C::FGW);
            bf16* dst = (isc ? YTC : YT) + ((size_t)b * C::BW + n) * 2 * L + im * L + t;
            dst[0] = f2bf(v[0]); dst[2 * L] = f2bf(v[1]); dst[4 * L] = f2bf(v[2]); dst[6 * L] = f2bf(v[3]); })
        return true;
    } };
__device__ __forceinline__ void el_ropetab(float* R, long idx) {
    constexpr int nf = C::AH / 4; const int t = (int)(idx / (C::AH / 2)), e = (int)(idx % (C::AH / 2)), half = e / nf, i = e % nf;
    const int pos = half == 0 ? t / C::GW : t % C::GW; const float inv = powf(10000.0f, -(float)i / (float)nf), ang = (float)pos * inv;
    R[2 * idx] = cosf(ang); R[2 * idx + 1] = sinf(ang);
}
__device__ __forceinline__ void el_rope_fast(const Ctx& c, long idx) {
    constexpr int PPR = (C::BW + C::AKVW) / 2, nf = C::AH / 4;
    const int row = (int)(idx / PPR), pp = (int)(idx % PPR); const bool isq = pp < C::BW / 2; const int p2 = isq ? pp : pp - C::BW / 2;
    const int hd = p2 / (C::AH / 2), e = p2 % (C::AH / 2), half = e / nf, i = e % nf, d1 = half * (C::AH / 2) + i, d2 = d1 + nf;
    const bf16* src = c.PX() + (size_t)row * C::PXW + (isq ? C::O_Q : C::O_KV) + hd * C::AH;
    bf16* dst = (isq ? c.QR() + (size_t)row * C::BW : c.KR() + (size_t)row * C::AKVW) + hd * C::AH;
    const float u1 = bf2f(src[d1]), u2 = bf2f(src[d2]);
    if (row >= C::MX) { dst[d1] = src[d1]; dst[d2] = src[d2]; return; }
    const int t = row % C::S; const float cs = c.ROPE()[((size_t)t * (C::AH / 2) + e) * 2], sn = c.ROPE()[((size_t)t * (C::AH / 2) + e) * 2 + 1];
    dst[d1] = f2bf(u1 * cs - u2 * sn); dst[d2] = f2bf(u2 * cs + u1 * sn);
}
constexpr int CV_T = 16, CV_ROWS = CV_T + C::CK - 1, CV_RSTR = 2 * C::BW * 2 + 16, CV_OFF = CV_ROWS * CV_RSTR;
static_assert(CV_OFF + CV_T * C::BW * 4 <= RING_BYTES, "conv LDS");
__device__ __forceinline__ void conv_phase(const Ctx& c, int l, int nrows, LAS unsigned char* lds, int tid, int vcu, int G) {
    LAS float* cv = (LAS float*)(lds + CV_OFF);
    const int ch = tid, lane = tid & 63, wave = __builtin_amdgcn_readfirstlane(tid >> 6);
    constexpr int PAD = (C::CK - 1) / 2, CPR = 2 * C::BW / 8;
    float dw[C::CK];
#pragma unroll
    for (int j = 0; j < C::CK; ++j) dw[j] = c.conv_dw()[((size_t)l * C::CK + j) * C::BW + ch];
    const float bias = c.conv_dw_b()[l * C::BW + ch];
    for (int unit = vcu; unit < nrows / CV_T; unit += G) {
        const int row0 = unit * CV_T; int b, t0, L, base; bool isc; row_info<C>(row0, b, t0, L, base, isc);
        for (int it = tid; it < CV_ROWS * CPR; it += NTHR) { const int ti = it / CPR, c8 = it - ti * CPR, t = t0 - PAD + ti;
            v4u val = {0u, 0u, 0u, 0u}; if (t >= 0 && t < L) val = *(const v4u*)(c.PX() + (size_t)(base + t) * C::PXW + C::O_CONV + c8 * 8);
            *(LAS v4u*)(lds + ti * CV_RSTR + c8 * 16) = val; }
        __syncthreads();
        float gl[CV_ROWS];
#pragma unroll
        for (int i = 0; i < CV_ROWS; ++i) { const LAS bf16* p = (const LAS bf16*)(lds + i * CV_RSTR); gl[i] = bf2f(p[ch]) * fast_sigmoid(bf2f(p[C::BW + ch])); }
#pragma unroll
        for (int i = 0; i < CV_T; ++i) { float s_ = bias;
#pragma unroll
            for (int j = 0; j < C::CK; ++j) s_ += gl[i + j] * dw[j];
            cv[i * C::BW + ch] = s_; }
        __syncthreads();
#pragma unroll
        for (int q = 0; q < CV_T / NWAVES; ++q) { const int i = wave * (CV_T / NWAVES) + q; float v[C::BW / 64]; float sm = 0.f;
#pragma unroll
            for (int e = 0; e < C::BW / 64; ++e) { v[e] = cv[i * C::BW + e * 64 + lane]; sm += v[e]; }
            const float mean = wave_sum(sm) * (1.0f / C::BW); float sq = 0.f;
#pragma unroll
            for (int e = 0; e < C::BW / 64; ++e) { v[e] -= mean; sq += v[e] * v[e]; }
            const float rs = 1.0f / sqrtf(wave_sum(sq) * (1.0f / C::BW) + 1e-5f);
#pragma unroll
            for (int e = 0; e < C::BW / 64; ++e) { const int k = e * 64 + lane; const float y = v[e] * rs * c.conv_ln_g()[l * C::BW + k] + c.conv_ln_b()[l * C::BW + k];
                c.FEATS()[(size_t)(row0 + i) * C::D + 3 * C::BW + k] = f2bf(y * fast_sigmoid(y)); } }
        __syncthreads();
    }
}
__device__ __forceinline__ void mod_partial_phase(const Ctx& c, LAS unsigned char* lds, int tid, int vcu, int G) {
    LAS float* sv = (LAS float*)lds;
    constexpr int NKC = C::D / 64, NCC = 6 * C::D / 2048, NU = C::DEPTH * NKC * NCC;
    static_assert(NKC == 32, "MODP holds 32 k chunks");
    for (int unit = vcu; unit < NU; unit += G) {
        const int cc = unit % NCC, kc = (unit / NCC) % NKC, l = unit / (NCC * NKC), k0 = kc * 64, col = cc * 2048 + tid * 4;
        if (tid < (C::B + 1) * 64) { const int r = tid / 64, k = tid % 64; const float x = r < C::B ? c.c()[r * C::D + k0 + k] : c.c_ctx()[k0 + k]; sv[tid] = x * sigmoidf_(x); }
        __syncthreads();
        f32x4 acc[C::B + 1];
#pragma unroll
        for (int r = 0; r <= C::B; ++r) acc[r] = (f32x4){0.f, 0.f, 0.f, 0.f};
        const float* wp = c.ada_w() + ((size_t)l * C::D + k0) * 6 * C::D + col;
#pragma unroll 8
        for (int k = 0; k < 64; ++k) { const f32x4 w = *(const f32x4*)(wp + (size_t)k * 6 * C::D);
#pragma unroll
            for (int r = 0; r <= C::B; ++r) acc[r] += sv[r * 64 + k] * w; }
#pragma unroll
        for (int r = 0; r <= C::B; ++r) *(f32x4*)(c.MODP() + (((size_t)kc * C::DEPTH + l) * (C::B + 1) + r) * 6 * C::D + col) = acc[r];
        __syncthreads();
    }
}
__device__ __forceinline__ void el_mod_reduce(const Ctx& c, long idx) {
    const int j = (int)(idx % (6 * C::D)); const int l = (int)(idx / ((long)(C::B + 1) * 6 * C::D));
    float s_ = c.ada_b()[l * 6 * C::D + j];
    for (int kc = 0; kc < 32; ++kc) s_ += c.MODP()[(size_t)kc * C::DEPTH * (C::B + 1) * 6 * C::D + idx];
    c.MOD()[idx] = s_;
}
__device__ __forceinline__ void hx_phase(const Ctx& c, int l, int which, int nrows, int lane, int gw, int NGW) {
    const float* gn = (which ? c.norm2_g() : c.norm1_g()) + l * C::D;
    for (int row = gw; row < nrows; row += NGW) {
        const float* xr = (l == 0 && which == 0) ? (row < C::MX ? c.x() + (size_t)row * C::D : c.ctx() + (size_t)(row - C::MX) * C::D) : c.X() + (size_t)row * C::D;
        const float* m = c.MOD() + ((size_t)l * (C::B + 1) + mod_row<C>(row)) * 6 * C::D;
        f32x4 v[C::D / 256]; float s_ = 0.f;
#pragma unroll
        for (int j = 0; j < C::D / 256; ++j) { v[j] = *(const f32x4*)(xr + (j * 64 + lane) * 4); s_ += (v[j][0] * v[j][0] + v[j][1] * v[j][1]) + (v[j][2] * v[j][2] + v[j][3] * v[j][3]); }
        const float rs = 1.0f / sqrtf(wave_sum(s_) * (1.0f / C::D) + 1e-6f);
#pragma unroll
        for (int j = 0; j < C::D / 256; ++j) { const int col = (j * 64 + lane) * 4; const f32x4 g = *(const f32x4*)(gn + col), sh = *(const f32x4*)(m + (which ? 3 : 0) * C::D + col), sc = *(const f32x4*)(m + (which ? 4 : 1) * C::D + col);
            const f32x4 y = v[j] * rs * g * (1.0f + sc) + sh; u32x2 w; w.x = cvtpk(y[0], y[1]); w.y = cvtpk(y[2], y[3]); *(u32x2*)(c.HX() + (size_t)row * C::D + col) = w; }
    }
}

__device__ __forceinline__ void convert_weights(const Ctx& c, int kind, int l, LAS float* scr, int lane, int wv, int nwv, int tid, long gt, long gts) {
    if (kind == 0) {
        constexpr int I_IN = (C::D / 64) * (C::IN_W / 64), I_B = (C::BW / 64) * (C::D / 64), I_O = (C::D / 64) * (C::D / 64);
        for (int it = wv; it < I_IN + 4 * I_B + I_O; it += nwv) {
            int r = it;
            if (r < I_IN) { transpose_item64(c.w_in() + (size_t)l * C::D * C::IN_W, C::D, C::IN_W, c.WinT(), scr, r, lane); continue; } r -= I_IN;
            if (r < 4 * I_B) { const int br = r / I_B; transpose_item64(c.w_branch() + ((size_t)l * 4 + br) * C::BW * C::D, C::BW, C::D, c.WbT() + (size_t)br * C::D * C::BW, scr, r % I_B, lane); continue; } r -= 4 * I_B;
            transpose_item64(c.w_out() + (size_t)l * C::D * C::D, C::D, C::D, c.WoT(), scr, r, lane);
        }
        for (long i = gt; i < (long)(C::PXW - C::IN_W) * C::D; i += gts) c.WinT()[(long)C::IN_W * C::D + i] = (bf16)0;
    } else {
        constexpr int I_1 = (C::D / 64) * (C::HID / 64), I_2 = (C::HID / 64) * (C::D / 64);
        for (int it = wv; it < I_1 + I_2; it += nwv) {
            if (it < I_1) transpose_item64(c.w_mlp1() + (size_t)l * C::D * C::HID, C::D, C::HID, c.W1T(), scr, it, lane);
            else transpose_item64(c.w_mlp2() + (size_t)l * C::HID * C::D, C::HID, C::D, c.W2T(), scr, it - I_1, lane);
        }
    }
    (void)tid;
}

struct Args { const float* in[30]; float* out; unsigned char* ws; };

__global__ void __launch_bounds__(NTHR, 2) mega_fwd(Args args) {
    extern __shared__ __attribute__((aligned(16))) unsigned char lds_raw[];
    LAS unsigned char* lds = (LAS unsigned char*)lds_raw;
    const int tid = threadIdx.x, lane = tid & 63, wave = __builtin_amdgcn_readfirstlane(tid >> 6);
    const int G = gridDim.x; const int bx = blockIdx.x; const int vcu = (G % 8 == 0) ? (bx % 8) * (G / 8) + bx / 8 : bx;
    const long gstride = (long)G * NTHR;
    const int gw = vcu * NWAVES + wave, NGW = G * NWAVES;
    typedef const CONSTAS Args* KArgs;
    KArgs ka = (KArgs)__builtin_amdgcn_kernarg_segment_ptr();
    unsigned char* ws = ka->ws;
#define PHASE_CTX() int tidp = threadIdx.x; asm volatile("" : "+v"(tidp)); const int lanep = tidp & 63; const long gtidp = (long)vcu * NTHR + tidp; Ctx c; { KArgs k_ = ka; asm volatile("" : "+s"(k_)); c.in = k_->in; c.out = k_->out; c.ws = k_->ws; }
    for (int u = tid; u < (LDS_BYTES - LDSCTL_OFF) / 4; u += NTHR) ((LAS unsigned*)(lds + LDSCTL_OFF))[u] = 0u;
    __syncthreads();
    volatile LAS unsigned* MISC = (volatile LAS unsigned*)(lds + MISC_OFF);
    XcdBarrier bar = xcd_barrier_post((unsigned*)(ws + WSMap::CTL) + CW_BAR, MISC + 8, (unsigned)G, true);
    const bool split = (G == 256); const bool is_scan = split && (vcu & 31) < 8;
    const int sidx = (vcu >> 5) * 8 + (vcu & 31), nidx = split ? (vcu >> 5) * 24 + (vcu & 31) - 8 : vcu, NG2 = split ? 192 : G;
    XcdBarrier bar2 = xcd_barrier_post((unsigned*)(ws + WSMap::CTL) + CW_BAR + XCD_BAR_WORDS, MISC + 10, 192u, split && !is_scan);
#define GRID_BAR() do { xcd_barrier(bar); if ((PROBE) == 99) xcd_barrier(bar); } while (0)
#define SUB_BAR() do { if (split) xcd_barrier(bar2); else xcd_barrier(bar); } while (0)
#define GSL(n, body) do { for (long i_ = gtidp; i_ < (long)(n); i_ += gstride) { body; } } while (0)
    LAS float* scr = (LAS float*)(lds + wave * 16384);

    RP(0) { PHASE_CTX();
#if EN_EL_DFT_TABLE
    GSL((long)C::S * 2 * C::S, el_dft_table<C>(c.TX(), C::S, i_));
#endif
#if EN_EL_DFT_TABLE
    GSL((long)C::CT * 2 * C::CT, el_dft_table<C>(c.TC(), C::CT, i_));
#endif
    GSL((long)2 * C::BW * C::BW, el_tbd(c.TBD(), i_));
    GSL((long)C::S * (C::AH / 2), el_ropetab(c.ROPE(), i_));
    mod_partial_phase(c, lds, tidp, vcu, G);
        }
    GRID_BAR();

    for (int l = 0; l < C::DEPTH; ++l) {
        const bool wc = l < C::DEPTH - 1; const int nrows = wc ? C::MA : C::MX; const int nMr = nrows / 256;
        if (l == 0) {
        RP(1) { PHASE_CTX();
            convert_weights(c, 0, 0, scr, lanep, gw, NGW, tidp, gtidp, gstride);
            GSL((long)C::DEPTH * (C::B + 1) * 6 * C::D, el_mod_reduce(c, i_));
        }
        GRID_BAR();
        }
        RP(2) { PHASE_CTX(); hx_phase(c, l, 0, C::MA, lanep, gw, NGW); }
        GRID_BAR();
        constexpr int NSTT = C::O_KV / 256;
        static_assert(C::O_KV % 256 == 0, "state columns end on a tile boundary");
        const int nsc = G >= 256 ? 64 : 0;
        RP(3) { PHASE_CTX();
            pg8::Gemm g{c.HX(), c.WinT(), C::D, C::D, C::D};
            pg8::RectSched S; S.G = G; S.c = vcu; S.nbr = 1; S.lda2 = (long)C::D * 2; S.ldb2 = (long)C::D * 2; S.abr = 0; S.bbr = 0;
            S.pm0_0 = 0; S.nM_0 = C::MX / 256; S.pn0_0 = 0; S.nN_0 = NSTT; S.blocked = true; S.bm = 4; S.bn = NSTT;
            S.pm0_1 = C::MX / 256; S.nM_1 = C::MC / 256; S.pn0_1 = 0; S.nN_1 = wc ? NSTT : C::CSC / 256;
            DEpiPX E{c.PX(), c.ROPE(), c.KR()};
            pg8::gemm_phase(lds, g, S, E, tidp);
        }
        GRID_BAR();
        { PHASE_CTX();
        RP(40) prep_mfma_phase(c, l, lds, tidp, vcu, G);
        }
        GRID_BAR();
        if (!split || is_scan) { PHASE_CTX();
            RP(50) scan64_phase(c, wc, lds, tidp, split ? sidx : vcu, split ? 64 : G);
        }
        if (!split) GRID_BAR();
        if (!split || !is_scan) {
            RP(31) { PHASE_CTX();
                pg8::Gemm g{c.HX(), c.WinT(), C::D, C::D, C::D};
                pg8::RectSched S; S.G = NG2; S.c = nidx; S.nbr = 1; S.lda2 = (long)C::D * 2; S.ldb2 = (long)C::D * 2; S.abr = 0; S.bbr = 0;
                S.pm0_0 = 0; S.nM_0 = C::MX / 256; S.pn0_0 = NSTT; S.nN_0 = C::PXW / 256 - NSTT; if (split && (C::PXW / 256 - NSTT) % 6 == 0) { S.blocked = true; S.bm = 4; S.bn = 6; }
                S.pm0_1 = C::MX / 256; S.nM_1 = C::MC / 256; S.pn0_1 = NSTT; S.nN_1 = wc ? C::PXW / 256 - NSTT : 0;
                DEpiPX E{c.PX(), c.ROPE(), c.KR()};
                pg8::gemm_phase(lds, g, S, E, tidp);
            }
            SUB_BAR();
            { PHASE_CTX();
            RP(42) conv_phase(c, l, nrows, lds, tidp, nidx, NG2);
            RP(43) {
                pg8::Gemm g{c.PX() + C::O_FNO, c.TBD(), C::PXW, C::BW, C::BW};
                pg8::RectSched S; S.G = NG2; S.c = nidx; S.nbr = 1; S.lda2 = (long)C::PXW * 2; S.ldb2 = (long)C::BW * 2; S.abr = 0; S.bbr = 0;
                S.pm0_0 = 0; int nMp = nMr; asm volatile("" : "+s"(nMp)); S.nM_0 = nMp; S.pn0_0 = 0; S.nN_0 = 2 * C::BW / 256; S.pm0_1 = 0; S.nM_1 = 0; S.pn0_1 = 0; S.nN_1 = 0;
                DEpiFnoA E{c.YT(), c.YTC()};
                pg8::gemm_phase(lds, g, S, E, tidp);
            }
            }
            SUB_BAR();
            RP(52) { PHASE_CTX();
                pg8::Gemm g{c.TX(), c.YT(), 2 * C::S, 2 * C::S, 2 * C::S};
                pg8::RectSched S; S.G = NG2; S.c = nidx; S.nbr = 1; S.lda2 = (long)2 * C::S * 2; S.ldb2 = (long)2 * C::S * 2; S.abr = 0; S.bbr = 0;
                S.pm0_0 = 0; S.nM_0 = C::S / 256; S.pn0_0 = 0; S.nN_0 = C::B * C::BW / 256; S.pm0_1 = 0; S.nM_1 = 0; S.pn0_1 = 0; S.nN_1 = 0;
                DEpiFno E{c.FEATS(), C::S, 0};
                pg8::gemm_phase(lds, g, S, E, tidp);
            }
            if (wc) { PHASE_CTX();
                pg8::Gemm g{c.TC(), c.YTC(), 2 * C::CT, 2 * C::CT, 2 * C::CT};
                pg8::RectSched S; S.G = NG2; S.c = (nidx + NG2 - 64) % NG2; S.nbr = 1; S.lda2 = (long)2 * C::CT * 2; S.ldb2 = (long)2 * C::CT * 2; S.abr = 0; S.bbr = 0;
                S.pm0_0 = 0; S.nM_0 = C::CT / 256; S.pn0_0 = 0; S.nN_0 = C::B * C::BW / 256; S.pm0_1 = 0; S.nM_1 = 0; S.pn0_1 = 0; S.nN_1 = 0;
                DEpiFno E{c.FEATS(), C::CT, C::MX};
                pg8::gemm_phase(lds, g, S, E, tidp);
            }
            { PHASE_CTX();
            const int na = NG2 > 144 ? NG2 - 72 : NG2;
            if (na == NG2 || nidx >= 72) RP(51) attn_phase(c, l, wc, lds, tidp, na == NG2 ? nidx : nidx - 72, na);
            }
        }
        GRID_BAR();
        RP(6) { PHASE_CTX(); readout_mfma_phase(c, l, nrows, lds, tidp, vcu, G); }
        GRID_BAR();
        RP(7) { PHASE_CTX();
            pg8::Gemm g{c.FEATS(), c.WbT(), C::D, C::BW, C::BW};
            pg8::RectSched S; S.G = G; S.c = vcu; S.nbr = 4; S.lda2 = (long)C::D * 2; S.ldb2 = (long)C::BW * 2; S.abr = (long)C::BW * 2; S.bbr = (long)C::D * C::BW * 2;
            S.pm0_0 = 0; int nMp = nMr; asm volatile("" : "+s"(nMp)); S.nM_0 = nMp; S.pn0_0 = 0; S.nN_0 = C::D / 256; S.pm0_1 = 0; S.nM_1 = 0; S.pn0_1 = 0; S.nN_1 = 0; S.blocked = true;
            DEpiMerge E{c.PX(), c.MIX()};
            pg8::gemm_phase(lds, g, S, E, tidp);
            { const int ntl = nMr * (C::D / 256), n2 = ntl > G ? ntl - G : 0;
              if (vcu >= n2) convert_weights(c, 1, l, scr, lanep, (vcu - n2) * NWAVES + wave, (G - n2) * NWAVES, tidp, 0, 1); }
        }
        GRID_BAR();
        { PHASE_CTX();
            const int ntl = nMr * (C::D / 256);
            if (ntl > G && (ntl * 8) % G == 0 && ntl * 8 / G >= 8) {
                pg8::Gemm g{c.MIX(), c.WoT(), C::D, C::D, C::D / 8};
                pg8::ChainSched S; S.G = G; S.c = vcu; int nMp = nMr; asm volatile("" : "+s"(nMp)); S.nM = nMp; S.ntl = ntl; S.nsl = 8; S.per = ntl * 8 / G; S.lda2 = (long)C::D * 2; S.ldb2 = (long)C::D * 2; S.ksl = (long)(C::D / 8) * 2;
                DEpiResChain E{c.X(), c.MOD() + (size_t)l * (C::B + 1) * 6 * C::D + 2 * C::D, (unsigned*)(c.ws + WSMap::CTL) + CW_FLAGS + (2 * l) * FLAG_BANK, nMp, l == 0 ? c.x() : nullptr, c.ctx()};
                pg8::gemm_phase(lds, g, S, E, tidp);
            } else {
            pg8::Gemm g{c.MIX(), c.WoT(), C::D, C::D, C::D};
            pg8::RectSched S; S.G = G; S.c = vcu; S.nbr = 1; S.lda2 = (long)C::D * 2; S.ldb2 = (long)C::D * 2; S.abr = 0; S.bbr = 0;
            S.pm0_0 = 0; int nMp = nMr; asm volatile("" : "+s"(nMp)); S.nM_0 = nMp; S.pn0_0 = 0; S.nN_0 = C::D / 256; S.pm0_1 = 0; S.nM_1 = 0; S.pn0_1 = 0; S.nN_1 = 0; S.blocked = true;
            DEpiRes E{c.X(), c.MOD() + (size_t)l * (C::B + 1) * 6 * C::D + 2 * C::D, l == 0 ? c.x() : nullptr, c.ctx()};
            pg8::gemm_phase(lds, g, S, E, tidp);
            }
        }
        GRID_BAR();
        RP(9) { PHASE_CTX();
            hx_phase(c, l, 1, nrows, lanep, gw, NGW);
        }
        GRID_BAR();
        RP(10) { PHASE_CTX();
            pg8::Gemm g{c.HX(), c.W1T(), C::D, C::D, C::D};
            pg8::RectSched S; S.G = G; S.c = vcu; S.nbr = 1; S.lda2 = (long)C::D * 2; S.ldb2 = (long)C::D * 2; S.abr = 0; S.bbr = 0;
            S.pm0_0 = 0; int nMp = nMr; asm volatile("" : "+s"(nMp)); S.nM_0 = nMp; S.pn0_0 = 0; S.nN_0 = C::HID / 256; S.pm0_1 = 0; S.nM_1 = 0; S.pn0_1 = 0; S.nN_1 = 0; S.blocked = true;
            DEpiMlp1 E{c.U()};
#if EN_GEMM && (GEMM_MASK & 32)
            pg8::gemm_phase(lds, g, S, E, tidp);
#endif
        }
        GRID_BAR();
        { PHASE_CTX();
            const int ntl = nMr * (C::D / 256), n2 = ntl > G ? ntl - G : 0;
            if (ntl > G && (ntl * 8) % G == 0 && ntl * 8 / G >= 8) {
                pg8::Gemm g{c.U(), c.W2T(), C::HID, C::HID, C::HID / 8};
                pg8::ChainSched S; S.G = G; S.c = vcu; int nMp = nMr; asm volatile("" : "+s"(nMp)); S.nM = nMp; S.ntl = ntl; S.nsl = 8; S.per = ntl * 8 / G; S.lda2 = (long)C::HID * 2; S.ldb2 = (long)C::HID * 2; S.ksl = (long)(C::HID / 8) * 2;
                DEpiResChain E{c.X(), c.MOD() + (size_t)l * (C::B + 1) * 6 * C::D + 5 * C::D, (unsigned*)(c.ws + WSMap::CTL) + CW_FLAGS + (2 * l + 1) * FLAG_BANK, nMp, nullptr, nullptr};
                pg8::gemm_phase(lds, g, S, E, tidp);
                if (l + 1 < C::DEPTH) convert_weights(c, 0, l + 1, scr, lanep, gw, NGW, tidp, gtidp, gstride);
            } else {
            pg8::Gemm g{c.U(), c.W2T(), C::HID, C::HID, C::HID};
            pg8::RectSched S; S.G = G; S.c = vcu; S.nbr = 1; S.lda2 = (long)C::HID * 2; S.ldb2 = (long)C::HID * 2; S.abr = 0; S.bbr = 0;
            S.pm0_0 = 0; int nMp = nMr; asm volatile("" : "+s"(nMp)); S.nM_0 = nMp; S.pn0_0 = 0; S.nN_0 = C::D / 256; S.pm0_1 = 0; S.nM_1 = 0; S.pn0_1 = 0; S.nN_1 = 0; S.blocked = true;
            DEpiRes E{c.X(), c.MOD() + (size_t)l * (C::B + 1) * 6 * C::D + 5 * C::D, nullptr, nullptr};
            pg8::gemm_phase(lds, g, S, E, tidp);
            if (l + 1 < C::DEPTH) { if (vcu >= n2) convert_weights(c, 0, l + 1, scr, lanep, (vcu - n2) * NWAVES + wave, (G - n2) * NWAVES, tidp, (long)(vcu - n2) * NTHR + tidp, (long)(G - n2) * NTHR); }
            }
        }
        GRID_BAR();
    }
    PHASE_CTX();
    for (int row = gw; row < C::MX; row += NGW) {
        const float* xr = c.X() + (size_t)row * C::D; float s = 0.f;
        for (int j = lanep; j < C::D; j += 64) s += xr[j] * xr[j];
        s = wave_sum(s); const float rs = 1.0f / sqrtf(s / (float)C::D + 1e-6f);
        for (int j = lanep; j < C::D; j += 64) c.out[(size_t)row * C::D + j] = xr[j] * rs * c.final_g()[j];
    }
}

extern "C" void kernel_launch(void* const* d_in, const int* in_sizes, int n_in, void* d_out, int out_size, void* d_ws, size_t ws_size, hipStream_t stream) {
    static int grid = 0;
    if (grid == 0) {
        if (n_in != 30 || out_size != C::MX * C::D || ws_size < WSMap::END) { fprintf(stderr, "kernel_launch: bad shapes: n_in %d out %d ws %zu (need %zu)\n", n_in, out_size, ws_size, (size_t)WSMap::END); grid = -1; return; }
        int dev = 0, cus = 0, per_cu = 0;
        if (hipGetDevice(&dev) != hipSuccess || hipDeviceGetAttribute(&cus, hipDeviceAttributeMultiprocessorCount, dev) != hipSuccess) { grid = -1; return; }
        if (hipFuncSetAttribute((const void*)mega_fwd, hipFuncAttributeMaxDynamicSharedMemorySize, LDS_BYTES) != hipSuccess) { fprintf(stderr, "kernel_launch: hipFuncSetAttribute failed\n"); grid = -1; return; }
        if (hipOccupancyMaxActiveBlocksPerMultiprocessor(&per_cu, (const void*)mega_fwd, NTHR, LDS_BYTES) != hipSuccess || per_cu < 1) { fprintf(stderr, "kernel_launch: occupancy query says %d\n", per_cu); grid = -1; return; }
        (void)hipGetLastError();
        grid = cus;
    }
    if (grid < 0) return;
    if (hipMemsetAsync((char*)d_ws + WSMap::CTL, 0, WSMap::CTL_BYTES, stream) != hipSuccess) return;
    Args a{};
    for (int i = 0; i < 30; ++i) a.in[i] = (const float*)d_in[i];
    a.out = (float*)d_out; a.ws = (unsigned char*)d_ws;
    hipLaunchKernelGGL(mega_fwd, dim3(grid), dim3(NTHR), LDS_BYTES, stream, a);
}
```
